# Optimizing an MI355X kernel written in HIP

```python
import math
import jax, jax.numpy as jnp
from jax import lax
import numpy as np

D_MODEL = 1024
BATCH = 8
SEQ = 4096
DEPTH = 2

HEAD_DIM = 64
N_HEADS = D_MODEL // HEAD_DIM
SB_HEADS = N_HEADS // 4
DIL_HEADS = N_HEADS - SB_HEADS
DIL_PATTERNS = ((128, 1), (512, 4), (2048, 16))
DIL_GROUP_HEADS = DIL_HEADS // len(DIL_PATTERNS)
OUT_WIDTH = (SB_HEADS + DIL_GROUP_HEADS) * HEAD_DIM
BLOCK = 128
N_BUCKETS = 32
MAX_DISTANCE = 2048
D_FF = 2816
RWKV_HEAD = 64
RWKV_HEADS = D_MODEL // RWKV_HEAD
D_DECAY_LORA = 64
D_AAA_LORA = 64
D_GATE_LORA = 160
NORM_EPS = 1e-6
GN_EPS = 64e-5
NEG_INF = -1e30
N_EVEN = (DEPTH + 1) // 2
N_ODD = DEPTH // 2

kernel_name = "hybrid_stickbreak_dilated_rwkv7_macaron"


def rms_norm(x, g, eps=NORM_EPS):
    x32 = x.astype(jnp.float32)
    y = x32 * lax.rsqrt(jnp.mean(x32 * x32, axis=-1, keepdims=True) + eps)
    return (y * g.astype(jnp.float32)).astype(x.dtype)


def swiglu(h, w_gate, w_up, w_down):
    return (jax.nn.silu(h @ w_gate) * (h @ w_up)) @ w_down


def t5_bucket(dist):
    max_exact = N_BUCKETS // 2
    d = jnp.maximum(dist, 1).astype(jnp.float32)
    large = max_exact + (jnp.log(d / max_exact) / math.log(MAX_DISTANCE / max_exact)
                         * (N_BUCKETS - max_exact)).astype(jnp.int32)
    large = jnp.minimum(large, N_BUCKETS - 1)
    return jnp.where(dist < max_exact, dist, large)


def stick_breaking_attention(q, k, v):
    B, S, H, Dh = q.shape
    nb = S // BLOCK
    scale = Dh ** -0.5
    qb = q.reshape(B, nb, BLOCK, H, Dh).transpose(1, 0, 3, 2, 4)
    kpos = jnp.arange(S)

    def one_block(args):
        qi, n = args
        z = jnp.einsum('bhqd,bshd->bhqs', qi, k).astype(jnp.float32) * scale
        qpos = n * BLOCK + jnp.arange(BLOCK)
        strict = kpos[None, :] < qpos[:, None]
        log_keep = jnp.where(strict, jax.nn.log_sigmoid(-z), 0.0)
        after = lax.cumsum(log_keep, axis=3, reverse=True) - log_keep
        weight = jnp.where(strict, jnp.exp(jax.nn.log_sigmoid(z) + after), 0.0)
        return jnp.einsum('bhqs,bshd->bqhd', weight.astype(v.dtype), v)

    out = lax.map(one_block, (qb, jnp.arange(nb)))
    return out.transpose(1, 0, 2, 3, 4).reshape(B, S, H, Dh)


def dilated_window_attention(q, k, v, bias_table, window, dilation):
    B, S, G, Dh = q.shape
    r = dilation
    L = S // r
    span = window // r
    nb = -(-L // BLOCK)
    Lp = nb * BLOCK

    def to_sub(t):
        t = t.reshape(B, L, r, G, Dh).transpose(0, 2, 1, 3, 4)
        t = jnp.pad(t, ((0, 0), (0, 0), (0, Lp - L), (0, 0), (0, 0)))
        return t.reshape(B, r, nb, BLOCK, G, Dh)

    def with_prev(t):
        prev = jnp.pad(t, ((0, 0), (0, 0), (1, 0), (0, 0), (0, 0), (0, 0)))[:, :, :-1]
        return jnp.concatenate([prev, t], axis=3)

    qs = to_sub(q)
    kw, vw = with_prev(to_sub(k)), with_prev(to_sub(v))
    logits = jnp.einsum('brnqgd,brnkgd->brngqk', qs, kw).astype(jnp.float32) * (Dh ** -0.5)
    qi = jnp.arange(BLOCK)[:, None]
    kj = jnp.arange(2 * BLOCK)[None, :] - BLOCK
    dist = qi - kj
    in_window = (dist >= 0) & (dist <= span)
    has_key = (jnp.arange(nb)[:, None, None] > 0) | (kj[None] >= 0)
    mask = (in_window[None] & has_key)[:, None]
    bias = bias_table[t5_bucket(jnp.maximum(dist, 0) * r)].astype(jnp.float32).transpose(2, 0, 1)
    logits = jnp.where(mask, logits + bias, NEG_INF)
    m = jnp.max(logits, axis=-1, keepdims=True)
    p = jnp.exp(logits - m)
    den = jnp.sum(p, axis=-1, keepdims=True)
    o = jnp.einsum('brngqk,brnkgd->brnqgd', (p / den).astype(v.dtype), vw)
    lse = (m + jnp.log(den))[..., 0].transpose(0, 1, 2, 4, 3)

    def from_sub(t):
        t = t.reshape((B, r, Lp) + t.shape[4:])[:, :, :L]
        return jnp.swapaxes(t, 1, 2).reshape((B, S) + t.shape[3:])

    return from_sub(o), from_sub(lse)


def parallel_attention_mixer(h, w_in, q_norm, k_norm, w_out, rel_bias):
    B, S, _ = h.shape
    proj = h @ w_in
    a_cols = 3 * SB_HEADS * HEAD_DIM
    sb = proj[..., :a_cols].reshape(B, S, 3, SB_HEADS, HEAD_DIM)
    dl = proj[..., a_cols:].reshape(B, S, 3, DIL_HEADS, HEAD_DIM)
    out_a = stick_breaking_attention(sb[:, :, 0], sb[:, :, 1], sb[:, :, 2])
    q = rms_norm(dl[:, :, 0], q_norm)
    k = rms_norm(dl[:, :, 1], k_norm)
    v = dl[:, :, 2]
    outs, lses = [], []
    for g, (window, dilation) in enumerate(DIL_PATTERNS):
        sl = slice(g * DIL_GROUP_HEADS, (g + 1) * DIL_GROUP_HEADS)
        o, l = dilated_window_attention(q[:, :, sl], k[:, :, sl], v[:, :, sl],
                                        rel_bias[:, sl], window, dilation)
        outs.append(o)
        lses.append(l)
    alpha = jax.nn.softmax(jnp.stack(lses, axis=0), axis=0)
    out_b = jnp.sum(alpha[..., None].astype(v.dtype) * jnp.stack(outs, axis=0), axis=0)
    merged = jnp.concatenate([out_a.reshape(B, S, -1), out_b.reshape(B, S, -1)], axis=-1)
    return merged @ w_out


def rwkv7_step(state, inp):
    r_t, w_t, k_t, v_t, a_t, b_t = inp
    sa = jnp.einsum('bhvk,bhk->bhv', state, a_t)
    state = (state * w_t[:, :, None, :] + sa[..., None] * b_t[:, :, None, :]
             + v_t[..., None] * k_t[:, :, None, :])
    return state, jnp.einsum('bhvk,bhk->bhv', state, r_t)


def rwkv7_time_mix(h, mix, w0, w1, w2, a0, a1, a2, g1, g2, k_k, k_a, r_k,
                   w_r, w_k, w_v, w_o, lnx_g, lnx_b):
    B, S, D = h.shape
    H, N = RWKV_HEADS, RWKV_HEAD
    f32 = jnp.float32
    xx = jnp.pad(h, ((0, 0), (1, 0), (0, 0)))[:, :-1] - h
    xr, xw, xk, xv, xa, xg = [h + xx * mix[i] for i in range(6)]
    r = (xr @ w_r).astype(f32)
    k = (xk @ w_k).astype(f32)
    v = (xv @ w_v).astype(f32)
    w_log = -jax.nn.softplus(-(w0 + jnp.tanh(xw @ w1) @ w2).astype(f32)) - 0.5
    decay = jnp.exp(-jnp.exp(w_log))
    a = jax.nn.sigmoid((a0 + (xa @ a1) @ a2).astype(f32))
    g = jax.nn.sigmoid(xg @ g1) @ g2
    heads = lambda t: t.reshape(B, S, H, N)
    kk = heads(k * k_k.astype(f32))
    kk = kk / jnp.maximum(jnp.sqrt(jnp.sum(kk * kk, axis=-1, keepdims=True)), 1e-12)
    k = k * (1.0 + (a - 1.0) * k_a.astype(f32))
    r_h, k_h, v_h, a_h, w_h = heads(r), heads(k), heads(v), heads(a), heads(decay)
    tm = lambda t: jnp.swapaxes(t, 0, 1)
    seqs = (tm(r_h), tm(w_h), tm(k_h), tm(v_h), tm(-kk), tm(kk * a_h))
    _, y = lax.scan(rwkv7_step, jnp.zeros((B, H, N, N), f32), seqs)
    y = jnp.swapaxes(y, 0, 1)
    mu = jnp.mean(y, axis=-1, keepdims=True)
    var = jnp.mean(jnp.square(y - mu), axis=-1, keepdims=True)
    y = ((y - mu) * lax.rsqrt(var + GN_EPS)).reshape(B, S, D)
    y = y * lnx_g.astype(f32) + lnx_b.astype(f32)
    y = y + (jnp.sum(r_h * k_h * r_k.astype(f32), axis=-1, keepdims=True) * v_h).reshape(B, S, D)
    return (y.astype(h.dtype) * g) @ w_o


def setup_inputs(seed: int = 0) -> dict:
    key = jax.random.key(seed)
    ks = iter(jax.random.split(key, 48))
    D = D_MODEL
    nrm = lambda shape, scale: jax.random.normal(next(ks), shape, jnp.float32) * scale
    uni = lambda shape, lo, hi: jax.random.uniform(next(ks), shape, jnp.float32, lo, hi)
    return {
        "x": nrm((BATCH, SEQ, D), 1.0),
        "ffn_norm": 1.0 + nrm((DEPTH, 2, D), 0.05),
        "ffn_w_gate": nrm((DEPTH, 2, D, D_FF), D ** -0.5),
        "ffn_w_up": nrm((DEPTH, 2, D, D_FF), D ** -0.5),
        "ffn_w_down": nrm((DEPTH, 2, D_FF, D), D_FF ** -0.5),
        "mix_norm": 1.0 + nrm((DEPTH, D), 0.05),
        "rel_bias": nrm((N_BUCKETS, DIL_HEADS), 0.3),
        "attn_w_in": nrm((N_EVEN, D, 3 * N_HEADS * HEAD_DIM), D ** -0.5),
        "attn_q_norm": 1.0 + nrm((N_EVEN, HEAD_DIM), 0.05),
        "attn_k_norm": 1.0 + nrm((N_EVEN, HEAD_DIM), 0.05),
        "attn_w_out": nrm((N_EVEN, OUT_WIDTH, D), OUT_WIDTH ** -0.5),
        "rw_mix": uni((N_ODD, 6, D), 0.0, 1.0),
        "rw_w0": uni((N_ODD, D), -4.0, 0.0),
        "rw_w1": nrm((N_ODD, D, D_DECAY_LORA), D ** -0.5),
        "rw_w2": nrm((N_ODD, D_DECAY_LORA, D), 0.1 * D_DECAY_LORA ** -0.5),
        "rw_a0": nrm((N_ODD, D), 0.1),
        "rw_a1": nrm((N_ODD, D, D_AAA_LORA), D ** -0.5),
        "rw_a2": nrm((N_ODD, D_AAA_LORA, D), 0.1 * D_AAA_LORA ** -0.5),
        "rw_g1": nrm((N_ODD, D, D_GATE_LORA), D ** -0.5),
        "rw_g2": nrm((N_ODD, D_GATE_LORA, D), D_GATE_LORA ** -0.5),
        "rw_kk": 0.85 + nrm((N_ODD, D), 0.05),
        "rw_ka": 1.0 + nrm((N_ODD, D), 0.05),
        "rw_rk": nrm((N_ODD, RWKV_HEADS, RWKV_HEAD), 0.1),
        "rw_wr": nrm((N_ODD, D, D), D ** -0.5),
        "rw_wk": nrm((N_ODD, D, D), D ** -0.5),
        "rw_wv": nrm((N_ODD, D, D), D ** -0.5),
        "rw_wo": nrm((N_ODD, D, D), D ** -0.5),
        "rw_lnx_g": 1.0 + nrm((N_ODD, D), 0.05),
        "rw_lnx_b": nrm((N_ODD, D), 0.01),
    }


def reference(x, ffn_norm, ffn_w_gate, ffn_w_up, ffn_w_down, mix_norm, rel_bias,
              attn_w_in, attn_q_norm, attn_k_norm, attn_w_out,
              rw_mix, rw_w0, rw_w1, rw_w2, rw_a0, rw_a1, rw_a2, rw_g1, rw_g2,
              rw_kk, rw_ka, rw_rk, rw_wr, rw_wk, rw_wv, rw_wo, rw_lnx_g, rw_lnx_b):
    for layer in range(DEPTH):
        x = x + 0.5 * swiglu(rms_norm(x, ffn_norm[layer, 0]), ffn_w_gate[layer, 0],
                             ffn_w_up[layer, 0], ffn_w_down[layer, 0])
        h = rms_norm(x, mix_norm[layer])
        if layer % 2 == 0:
            e = layer // 2
            x = x + parallel_attention_mixer(h, attn_w_in[e], attn_q_norm[e], attn_k_norm[e],
                                             attn_w_out[e], rel_bias)
        else:
            o = layer // 2
            x = x + rwkv7_time_mix(h, rw_mix[o], rw_w0[o], rw_w1[o], rw_w2[o], rw_a0[o],
                                   rw_a1[o], rw_a2[o], rw_g1[o], rw_g2[o], rw_kk[o], rw_ka[o],
                                   rw_rk[o], rw_wr[o], rw_wk[o], rw_wv[o], rw_wo[o],
                                   rw_lnx_g[o], rw_lnx_b[o])
        x = x + 0.5 * swiglu(rms_norm(x, ffn_norm[layer, 1]), ffn_w_gate[layer, 1],
                             ffn_w_up[layer, 1], ffn_w_down[layer, 1])
    return x
```

```cpp
#include <hip/hip_runtime.h>
#include <hip/hip_cooperative_groups.h>
#include <cstdio>
#ifdef SCAN_DEBUG
#define DBG_NAN 1
#define DBG_SEL 0
#endif
#ifndef DUPMASK
#define DUPMASK 0u
#endif

namespace cg = cooperative_groups;

#define DI __device__ __forceinline__
#define LAS __attribute__((address_space(3)))
typedef unsigned short bf16_t;
typedef short bf16x8 __attribute__((ext_vector_type(8)));
typedef short s16x4 __attribute__((ext_vector_type(4)));
typedef float f32x4 __attribute__((ext_vector_type(4)));
typedef float f32x2 __attribute__((ext_vector_type(2)));
typedef unsigned u32x4 __attribute__((ext_vector_type(4)));
typedef unsigned u32x2 __attribute__((ext_vector_type(2)));
typedef _Float16 h16x2 __attribute__((ext_vector_type(2)));

constexpr int T_TOK = 32768, DM = 1024, SEQ = 4096, DFF = 2816;
constexpr size_t MiB = 1ull << 20;
constexpr size_t WS_WIN = 0, WS_WOUT = 6 * MiB, WS_WR = 7 * MiB, WS_WK = 11 * MiB, WS_WV = 15 * MiB, WS_WO = 19 * MiB, WS_L1 = 21 * MiB,
                 WS_L2W = 23 * MiB, WS_L2A = 23 * MiB + 512 * 1024, WS_L2G = 24 * MiB, WS_BON = 25 * MiB, WS_LSE = 27 * MiB, WS_FLAGS = 30 * MiB, WS_BAR = 31 * MiB, WS_XS1 = 296 * MiB, WS_GU2 = 481 * MiB, WS_DN2 = 492 * MiB;
constexpr size_t WS_HN = 32 * MiB, WS_HID = 96 * MiB, WS_PROJ = 96 * MiB, WS_OG = 288 * MiB, WS_MERGED = 336 * MiB, WS_GU = 384 * MiB, WS_DN = 395 * MiB;
constexpr size_t RBUF = 64 * MiB + 65536;
constexpr size_t WS_B1 = 32 * MiB, WS_B2 = WS_B1 + RBUF, WS_B3 = WS_B2 + RBUF, WS_B4 = WS_B3 + RBUF, WS_B5 = WS_B4 + RBUF, WS_B6 = WS_B5 + RBUF, WS_B7 = WS_B6 + RBUF;
constexpr size_t WS_NEED = 498 * MiB;
constexpr int LDS_BYTES = 147456;

DI int my_tid_(int wv) { unsigned m = ~0u; asm volatile("" : "+s"(m)); const int l = (int)__builtin_amdgcn_mbcnt_hi(m, __builtin_amdgcn_mbcnt_lo(m, 0u)); return wv * 64 + l; }
#define my_tid() my_tid_(wv_)
DI int my_bid() { int t = blockIdx.x; asm volatile("" : "+s"(t)); return t; }
DI int my_nblk() { int t = gridDim.x; asm volatile("" : "+s"(t)); return t; }
typedef __bf16 bf16x2_t __attribute__((ext_vector_type(2)));
DI unsigned cvt_pk_bf16(float lo, float hi) { const f32x2 v = {lo, hi}; const bf16x2_t b = __builtin_convertvector(v, bf16x2_t); return __builtin_bit_cast(unsigned, b); }
DI float bf_lo(unsigned u) { return __uint_as_float(u << 16); }
DI float bf_hi(unsigned u) { return __uint_as_float(u & 0xffff0000u); }
DI float fast_exp(float x) { return __builtin_amdgcn_exp2f(x * 1.44269504089f); }
DI float fast_log(float x) { return __builtin_amdgcn_logf(x) * 0.69314718056f; }
DI float fast_rcp(float x) { return __builtin_amdgcn_rcpf(x); }
DI float sigmoidf_(float x) { return fast_rcp(1.0f + fast_exp(-x)); }

namespace pg8 {
constexpr int BM = 256, BK = 64, HALF = 128, HTB = HALF * BK * 2, STAGE_BYTES = 8 * HTB, NXCD = 8, WGM = 8;
DI int lds_byte(int r, int c) { const int st = (r >> 4) * 2 + (c >> 5), rr = r & 15, cc = c & 31, ob = rr * 64 + cc * 2; return st * 1024 + (ob ^ (((ob >> 9) & 1) << 5)); }
DI void stage_rc(int b_, int& R, int& C) { const unsigned b = (unsigned)b_; const unsigned st = b >> 10, sb = b & 1023u, swz = sb ^ (((sb >> 9) & 1u) << 5); R = (int)((st >> 1) * 16u + (swz >> 6)); C = (int)((st & 1u) * 32u + ((swz & 63u) >> 1)); }
DI int perm32(int rho) { const int n = rho >> 4, i = rho & 15; return 8 * (i >> 2) + 4 * n + (i & 3); }
struct Unit { int pm, pn; };
struct Gemm { const bf16_t* A; const bf16_t* Bt; int M, N, K, lda, ldb, gapA; };
struct StaticOrder {
    int nM, nN, nwg, G, c;
    DI void init(int M, int N, int G_, int c_) { nM = M / BM; nN = N / BM; nwg = nM * nN; G = G_; c = c_; }
    DI bool next(int i, Unit& u) const {
        const long L = (long)i * G + c; if (L >= nwg) return false;
        int wgid = (int)L; { const int q = nwg / NXCD, r = nwg % NXCD, xcd = wgid % NXCD, off = wgid / NXCD; wgid = (xcd < r ? xcd * (q + 1) : r * (q + 1) + (xcd - r) * q) + off; }
        const int nig = WGM * nN, gid = wgid / nig, fm = gid * WGM, gsz = (nM - fm) < WGM ? (nM - fm) : WGM;
        u.pm = fm + ((wgid % nig) % gsz); u.pn = (wgid % nig) / gsz; return true;
    }
};

template <class Epi>
DI void gemm_phase(const int wv_, LAS unsigned char* lds, const Gemm g, const StaticOrder& S, const Epi& E) {
    const int tid = my_tid(), wid = __builtin_amdgcn_readfirstlane(tid >> 6), lane = tid & 63, wr = wid >> 2, wc = wid & 3, fr = lane & 15, fq = lane >> 4;
    const int K = g.K, nt = K / BK;
    unsigned voffA[2], voffB[2];
#pragma unroll
    for (int i = 0; i < 2; ++i) { int R, C; stage_rc(tid * 16 + i * 8192, R, C); const int Rb = Epi::PERM ? ((R & ~31) + perm32(R & 31)) : R;
        voffA[i] = (unsigned)(R * g.lda + C) * 2u; voffB[i] = (unsigned)(Rb * g.ldb + C) * 2u; }
    const size_t kstep = (size_t)(BK * 2);
    const size_t hstepA = (size_t)HALF * g.lda * 2, hstepB = (size_t)HALF * g.ldb * 2;
    const size_t tstepA = 2 * hstepA, tstepB = 2 * hstepB;
    const unsigned ldsw = (unsigned)wid * 1024u;
    const int aoff = lds_byte(wr * 64 + fr, fq * 8), boff = lds_byte(wc * 32 + fr, fq * 8);
#define PG8_SA(b, h) (((b) * 2 + (h)) * HTB)
#define PG8_SB(b, h) ((4 + (b) * 2 + (h)) * HTB)
#define PG8_STAGE(bufoff, gbase, voff) do { _Pragma("unroll") for (int _i = 0; _i < 2; ++_i) { unsigned _vo = (voff)[_i]; asm volatile("" : "+v"(_vo)); \
        __builtin_amdgcn_global_load_lds((const unsigned*)((const char*)(gbase) + _vo), (LAS unsigned*)(lds + (bufoff) + ldsw + _i * 8192), 16, 0, 0); } } while (0)
#define PG8_LDA(dst, b, h) do { _Pragma("unroll") for (int m = 0; m < 4; ++m) _Pragma("unroll") for (int k = 0; k < 2; ++k) dst[m][k] = *(const LAS bf16x8*)(lds + PG8_SA(b, h) + aoff + m * 2048 + k * 1024); } while (0)
#define PG8_LDB(dst, b, h) do { _Pragma("unroll") for (int n = 0; n < 2; ++n) _Pragma("unroll") for (int k = 0; k < 2; ++k) dst[n][k] = *(const LAS bf16x8*)(lds + PG8_SB(b, h) + boff + n * 2048 + k * 1024); } while (0)
#define PG8_MMA(ai, bj, At, Bt) do { __builtin_amdgcn_s_setprio(1); _Pragma("unroll") for (int m = 0; m < 4; ++m) _Pragma("unroll") for (int n = 0; n < 2; ++n) _Pragma("unroll") for (int k = 0; k < 2; ++k) \
        acc[ai][bj][m][n] = __builtin_amdgcn_mfma_f32_16x16x32_bf16(Bt[n][k], At[m][k], acc[ai][bj][m][n], 0, 0, 0); __builtin_amdgcn_s_setprio(0); } while (0)
#define PG8_WAIT_V(n) asm volatile("s_waitcnt vmcnt(" #n ")" ::: "memory")
#define PG8_WAIT_L(n) asm volatile("s_waitcnt lgkmcnt(" #n ")" ::: "memory")
#define PG8_BAR __builtin_amdgcn_s_barrier()
#define PG8_SCHED __builtin_amdgcn_sched_barrier(0)
    Unit cur, nxt; int ui = 0;
    if (!S.next(0, cur)) return;
    f32x4 acc[2][2][4][2];
#pragma unroll
    for (int a = 0; a < 2; ++a)
#pragma unroll
        for (int b = 0; b < 2; ++b)
#pragma unroll
            for (int m = 0; m < 4; ++m)
#pragma unroll
                for (int n = 0; n < 2; ++n) acc[a][b][m][n] = (f32x4){0.f, 0.f, 0.f, 0.f};
    bf16x8 At[4][2], B0[2][2], B1[2][2];
    const char* cA = (const char*)g.A + (size_t)cur.pm * tstepA + (size_t)(cur.pm >> 4) * (size_t)g.gapA; const char* cB = (const char*)g.Bt + (size_t)cur.pn * tstepB;
    PG8_STAGE(PG8_SB(0, 0), cB, voffB); PG8_STAGE(PG8_SA(0, 0), cA, voffA); PG8_STAGE(PG8_SB(0, 1), cB + hstepB, voffB); PG8_STAGE(PG8_SA(0, 1), cA + hstepA, voffA);
    if (wr == 1) PG8_BAR;
    PG8_WAIT_V(4); PG8_BAR;
    PG8_STAGE(PG8_SB(1, 0), cB + kstep, voffB); PG8_STAGE(PG8_SA(1, 0), cA + kstep, voffA); PG8_STAGE(PG8_SB(1, 1), cB + hstepB + kstep, voffB);
    PG8_WAIT_V(6); PG8_BAR;
    for (;;) {
        const bool has_next = S.next(ui + 1, nxt);
        const char* nA = has_next ? (const char*)g.A + (size_t)nxt.pm * tstepA + (size_t)(nxt.pm >> 4) * (size_t)g.gapA : cA; const char* nB = has_next ? (const char*)g.Bt + (size_t)nxt.pn * tstepB : cB;
        for (int t = 0; t < nt; t += 2) {
            const bool last = (t == nt - 2);
            const char* a1 = cA + (size_t)(t + 1) * kstep;
            const char* a2 = last ? nA : cA + (size_t)(t + 2) * kstep; const char* b2 = last ? nB : cB + (size_t)(t + 2) * kstep;
            const char* a3 = a2 + kstep; const char* b3 = b2 + kstep;
            PG8_LDB(B0, 0, 0); PG8_SCHED; PG8_LDA(At, 0, 0); PG8_STAGE(PG8_SA(1, 1), a1 + hstepA, voffA);
            PG8_WAIT_L(8); PG8_BAR; PG8_WAIT_L(0); PG8_MMA(0, 0, At, B0); PG8_BAR; PG8_SCHED;
            PG8_LDB(B1, 0, 1); PG8_STAGE(PG8_SB(0, 0), b2, voffB);
            PG8_BAR; PG8_WAIT_L(0); PG8_MMA(0, 1, At, B1); PG8_BAR;
            PG8_LDA(At, 0, 1); PG8_STAGE(PG8_SA(0, 0), a2, voffA);
            PG8_BAR; PG8_WAIT_L(0); PG8_MMA(1, 0, At, B0); PG8_BAR; PG8_SCHED;
            PG8_STAGE(PG8_SB(0, 1), b2 + hstepB, voffB);
            PG8_WAIT_V(6); PG8_BAR; PG8_MMA(1, 1, At, B1); PG8_BAR;
            PG8_LDB(B0, 1, 0); PG8_SCHED; PG8_LDA(At, 1, 0); PG8_STAGE(PG8_SA(0, 1), a2 + hstepA, voffA);
            PG8_WAIT_L(8); PG8_BAR; PG8_WAIT_L(0); PG8_MMA(0, 0, At, B0); PG8_BAR; PG8_SCHED;
            PG8_LDB(B1, 1, 1); PG8_STAGE(PG8_SB(1, 0), b3, voffB);
            PG8_BAR; PG8_WAIT_L(0); PG8_MMA(0, 1, At, B1); PG8_BAR;
            PG8_LDA(At, 1, 1); PG8_STAGE(PG8_SA(1, 0), a3, voffA);
            PG8_BAR; PG8_WAIT_L(0); PG8_MMA(1, 0, At, B0); PG8_BAR; PG8_SCHED;
            PG8_STAGE(PG8_SB(1, 1), b3 + hstepB, voffB);
            PG8_WAIT_V(6); PG8_BAR; PG8_MMA(1, 1, At, B1); PG8_BAR;
        }
        { const int lane2 = my_tid() & 63; E(acc, cur, wr, wc, lane2 & 15, lane2 >> 4); }
        if (!has_next) break;
#pragma unroll
        for (int a = 0; a < 2; ++a)
#pragma unroll
            for (int b = 0; b < 2; ++b)
#pragma unroll
                for (int m = 0; m < 4; ++m)
#pragma unroll
                    for (int n = 0; n < 2; ++n) acc[a][b][m][n] = (f32x4){0.f, 0.f, 0.f, 0.f};
        cur = nxt; cA = nA; cB = nB; ++ui;
    }
    PG8_WAIT_V(0);
    if (wr == 0) PG8_BAR;
    PG8_BAR;
#undef PG8_SA
#undef PG8_SB
#undef PG8_STAGE
#undef PG8_LDA
#undef PG8_LDB
#undef PG8_MMA
#undef PG8_WAIT_V
#undef PG8_WAIT_L
#undef PG8_BAR
#undef PG8_SCHED
}
}
using pg8::Unit;

struct EpiSwiGLU {
    static constexpr bool PERM = true;
    bf16_t* H;
    DI void operator()(const f32x4 (&acc)[2][2][4][2], const Unit& u, int wr, int wc, int fr, int fq) const {
        const int row0 = u.pm * 256 + wr * 64 + fr, col0 = u.pn * 128 + wc * 32 + 8 * fq;
#pragma unroll
        for (int ai = 0; ai < 2; ++ai)
#pragma unroll
            for (int m = 0; m < 4; ++m) {
                bf16_t* rowp = H + (size_t)(row0 + ai * 128 + m * 16) * DFF + col0;
                float hv[8];
#pragma unroll
                for (int n = 0; n < 2; ++n)
#pragma unroll
                    for (int j = 0; j < 4; ++j) { const float gt = acc[ai][0][m][n][j], up = acc[ai][1][m][n][j]; hv[n * 4 + j] = gt * sigmoidf_(gt) * up; }
                u32x4 w; w.x = cvt_pk_bf16(hv[0], hv[1]); w.y = cvt_pk_bf16(hv[2], hv[3]); w.z = cvt_pk_bf16(hv[4], hv[5]); w.w = cvt_pk_bf16(hv[6], hv[7]);
                *(u32x4*)rowp = w;
            }
    }
};
template <bool BF> DI f32x4 ldx4(const void* X, size_t o) {
    if (BF) { const u32x2 w = *(const u32x2*)((const bf16_t*)X + o); return (f32x4){bf_lo(w.x), bf_hi(w.x), bf_lo(w.y), bf_hi(w.y)}; }
    else return *(const f32x4*)((const float*)X + o);
}
template <bool BF> DI void stx4(void* O, size_t o, const f32x4 r) {
    if (BF) { u32x2 w; w.x = cvt_pk_bf16(r[0], r[1]); w.y = cvt_pk_bf16(r[2], r[3]); *(u32x2*)((bf16_t*)O + o) = w; }
    else *(f32x4*)((float*)O + o) = r;
}
template <bool XBF, bool OBF> struct EpiResid {
    static constexpr bool PERM = false;
    const void* X; void* O; float scale;
    DI void operator()(const f32x4 (&acc)[2][2][4][2], const Unit& u, int wr, int wc, int fr, int fq) const {
        const int row0 = u.pm * 256 + wr * 64 + fr, col0 = u.pn * 256 + wc * 32 + 4 * fq;
#pragma unroll
        for (int ai = 0; ai < 2; ++ai)
#pragma unroll
            for (int m = 0; m < 4; ++m) {
                const size_t ro = (size_t)(row0 + ai * 128 + m * 16) * DM + col0;
#pragma unroll
                for (int bj = 0; bj < 2; ++bj)
#pragma unroll
                    for (int n = 0; n < 2; ++n) { const size_t o = ro + bj * 128 + n * 16; const f32x4 x = ldx4<XBF>(X, o); stx4<OBF>(O, o, x + acc[ai][bj][m][n] * scale); }
            }
    }
};
template <int MODE> struct EpiBf16 {
    static constexpr bool PERM = true;
    bf16_t* O; int ldc; const float* bias;
    DI void operator()(const f32x4 (&acc)[2][2][4][2], const Unit& u, int wr, int wc, int fr, int fq) const {
        const int row0 = u.pm * 256 + wr * 64 + fr, col0 = u.pn * 256 + wc * 32 + 8 * fq;
#pragma unroll
        for (int bj = 0; bj < 2; ++bj) {
            const int col = col0 + bj * 128;
            f32x4 b0 = (f32x4){0.f, 0.f, 0.f, 0.f}, b1 = b0;
            if (MODE >= 2) { b0 = *(const f32x4*)(bias + col); b1 = *(const f32x4*)(bias + col + 4); }
#pragma unroll
            for (int ai = 0; ai < 2; ++ai)
#pragma unroll
                for (int m = 0; m < 4; ++m) {
                    bf16_t* rowp = O + (size_t)(row0 + ai * 128 + m * 16) * ldc + col;
                    float v[8];
#pragma unroll
                    for (int j = 0; j < 4; ++j) { v[j] = acc[ai][bj][m][0][j] + b0[j]; v[4 + j] = acc[ai][bj][m][1][j] + b1[j]; }
                    u32x4 w;
                    if (MODE == 1) {
#pragma unroll
                        for (int j = 0; j < 8; ++j) {
                            float x = v[j];
                            if (col < 64) { const float e = fast_exp(-2.0f * fabsf(x)); const float th = (1.0f - e) * fast_rcp(1.0f + e); x = x < 0.f ? -th : th; }
                            else if (col < 128) { }
                            else if (col < 288) x = sigmoidf_(x);
                            else x = 0.f;
                            v[j] = x;
                        }
                    }
                    if (MODE == 3) {
#pragma unroll
                        for (int j = 0; j < 8; ++j) v[j] = sigmoidf_(v[j]);
                    }
                    if (MODE == 2) {
                        unsigned hw[4];
#pragma unroll
                        for (int j = 0; j < 4; ++j) {
                            float om[2];
#pragma unroll
                            for (int q = 0; q < 2; ++q) { const float x = v[2 * j + q];
                                const float e = 0.6065306597f * sigmoidf_(x); om[q] = 1.0f - fast_exp(-e); }
                            h16x2 hh; hh.x = (_Float16)om[0]; hh.y = (_Float16)om[1]; hw[j] = __builtin_bit_cast(unsigned, hh);
                        }
                        w.x = hw[0]; w.y = hw[1]; w.z = hw[2]; w.w = hw[3];
                    } else { w.x = cvt_pk_bf16(v[0], v[1]); w.y = cvt_pk_bf16(v[2], v[3]); w.z = cvt_pk_bf16(v[4], v[5]); w.w = cvt_pk_bf16(v[6], v[7]); }
                    *(u32x4*)rowp = w;
                    if (MODE != 0) asm volatile("" ::: "memory");
                }
        }
    }
};

template <class Epi> DI void run_gemm(const int wv_, LAS unsigned char* lds, const bf16_t* A, const bf16_t* Bt, int N, int K, int lda, int ldb, int gapA, const Epi& E, int G_ = -1, int c_ = 0) {
    pg8::Gemm g; g.A = A; g.Bt = Bt; g.M = T_TOK; g.N = N; g.K = K; g.lda = lda; g.ldb = ldb; g.gapA = gapA;
    pg8::StaticOrder S; if (G_ < 0) S.init(T_TOK, N, my_nblk(), my_bid()); else S.init(T_TOK, N, G_, c_);
    pg8::gemm_phase<Epi>(wv_, lds, g, S, E);
    __syncthreads();
}

struct ConvJob { const float* src; const float* scale; bf16_t* dst; int Ks, Ns, ldd, rb, NR, r0, cb, NC, c0, flags; int pad_; };
DI void conv_phase(const int wv_, const ConvJob* jobs, int j0, int j1, LAS unsigned char* lds, int G_ = -1, int c_ = 0) {
    LAS float* tile = (LAS float*)lds;
    const int tid = my_tid();
    int total = 0;
    for (int j = j0; j < j1; ++j) total += ((jobs[j].NR + 255) >> 8) * (jobs[j].NC >> 6);
    const int cstart = G_ < 0 ? my_bid() : c_, cstep = G_ < 0 ? my_nblk() : G_;
    for (int t = cstart; t < total; t += cstep) {
        int j = j0, tt = t;
        for (;; ++j) { const int nt = ((jobs[j].NR + 255) >> 8) * (jobs[j].NC >> 6); if (tt < nt) break; tt -= nt; }
        const ConvJob J = jobs[j];
        const int ntr = (J.NR + 255) >> 8; const int tr = tt % ntr, tc = tt / ntr;
        const int nrel0 = tr * 256, c0t = J.cb + tc * 64;
        const int smode = (J.flags >> 1) & 3;
#pragma unroll
        for (int q = 0; q < 8; ++q) {
            const int i = tid + q * 512, kl = i >> 6, n4 = i & 63;
            const int k = c0t + kl - J.c0, nrel = nrel0 + n4 * 4, n = J.rb + nrel - J.r0;
            f32x4 v = {0.f, 0.f, 0.f, 0.f};
            if (J.src != nullptr && k >= 0 && k < J.Ks && n >= 0 && n < J.Ns && nrel < J.NR) {
                v = *(const f32x4*)(J.src + (size_t)k * J.Ns + n);
                if (smode == 1) v = v * J.scale[k]; else if (smode == 2) v = v * (1.0f - J.scale[k]);
            }
            *(LAS f32x4*)(tile + kl * 260 + n4 * 4) = v;
        }
        __syncthreads();
#pragma unroll
        for (int q = 0; q < 4; ++q) {
            const int p = tid + q * 512, nl = p & 255, seg = p >> 8;
            const int nrel = nrel0 + nl;
            if (nrel < J.NR) {
                const LAS float* tp = tile + (8 * seg) * 260 + nl;
                u32x4 w; w.x = cvt_pk_bf16(tp[0], tp[260]); w.y = cvt_pk_bf16(tp[2 * 260], tp[3 * 260]); w.z = cvt_pk_bf16(tp[4 * 260], tp[5 * 260]); w.w = cvt_pk_bf16(tp[6 * 260], tp[7 * 260]);
                const int row = J.rb + ((J.flags & 1) ? ((nrel >> 7) * 256 + (nrel & 127)) : nrel);
                *(u32x4*)(J.dst + (size_t)row * J.ldd + c0t + 8 * seg) = w;
            }
        }
        __syncthreads();
    }
}

template <bool XBF> DI void norm_phase(const int wv_, const void* X, const float* g, bf16_t* out, int gap) {
    const int wave = my_bid() * 8 + (my_tid() >> 6), lane = my_tid() & 63, nw = my_nblk() * 8;
    f32x4 gv[4];
#pragma unroll
    for (int i = 0; i < 4; ++i) gv[i] = *(const f32x4*)(g + i * 256 + lane * 4);
    for (int row = wave; row < T_TOK; row += nw) {
        f32x4 v[4]; float ss = 0.f;
#pragma unroll
        for (int i = 0; i < 4; ++i) { v[i] = ldx4<XBF>(X, (size_t)row * DM + i * 256 + lane * 4); ss += v[i][0] * v[i][0] + v[i][1] * v[i][1] + v[i][2] * v[i][2] + v[i][3] * v[i][3]; }
#pragma unroll
        for (int o = 32; o >= 1; o >>= 1) ss += __shfl_xor(ss, o);
        const float rs = rsqrtf(ss * (1.0f / 1024.0f) + 1e-6f);
        const size_t orow = gap ? (size_t)row + (row >> 12) + 1 : (size_t)row;
        bf16_t* op = out + orow * DM;
#pragma unroll
        for (int i = 0; i < 4; ++i) { u32x2 w; w.x = cvt_pk_bf16(v[i][0] * rs * gv[i][0], v[i][1] * rs * gv[i][1]); w.y = cvt_pk_bf16(v[i][2] * rs * gv[i][2], v[i][3] * rs * gv[i][3]);
            *(u32x2*)(op + i * 256 + lane * 4) = w; }
        if (gap && (row & 4095) == 0) {
            bf16_t* zp = out + (orow - 1) * DM;
#pragma unroll
            for (int i = 0; i < 4; ++i) *(u32x2*)(zp + i * 256 + lane * 4) = (u32x2){0u, 0u};
        }
    }
}

DI void normmix_phase(const int wv_, const bf16_t* X, const float* g, const float* mix, bf16_t* hgap, bf16_t* xr, bf16_t* xk, bf16_t* xv) {
    const int wave = my_bid() * 8 + (my_tid() >> 6), lane = my_tid() & 63, nw = my_nblk() * 8;
    f32x4 gv[4], mr[4], mk[4], mv[4];
#pragma unroll
    for (int i = 0; i < 4; ++i) { gv[i] = *(const f32x4*)(g + i * 256 + lane * 4); mr[i] = *(const f32x4*)(mix + 0 * DM + i * 256 + lane * 4);
        mk[i] = *(const f32x4*)(mix + 2 * DM + i * 256 + lane * 4); mv[i] = *(const f32x4*)(mix + 3 * DM + i * 256 + lane * 4); }
    constexpr int R = 4;
    for (int row0 = wave * R; row0 < T_TOK; row0 += nw * R) {
        const bool first = (row0 & 4095) == 0;
        f32x4 v[R + 1][4]; float ss[R + 1];
#pragma unroll
        for (int i = 0; i < 4; ++i) v[0][i] = first ? (f32x4){0.f, 0.f, 0.f, 0.f} : ldx4<true>(X, (size_t)(row0 - 1) * DM + i * 256 + lane * 4);
#pragma unroll
        for (int r = 1; r <= R; ++r)
#pragma unroll
            for (int i = 0; i < 4; ++i) v[r][i] = ldx4<true>(X, (size_t)(row0 + r - 1) * DM + i * 256 + lane * 4);
#pragma unroll
        for (int r = 0; r <= R; ++r) { float s = 0.f;
#pragma unroll
            for (int i = 0; i < 4; ++i) s += v[r][i][0] * v[r][i][0] + v[r][i][1] * v[r][i][1] + v[r][i][2] * v[r][i][2] + v[r][i][3] * v[r][i][3];
            ss[r] = s; }
#pragma unroll
        for (int o = 32; o >= 1; o >>= 1)
#pragma unroll
            for (int r = 0; r <= R; ++r) ss[r] += __shfl_xor(ss[r], o);
        f32x4 hp[4];
        { const float rp = rsqrtf(ss[0] * (1.0f / 1024.0f) + 1e-6f);
#pragma unroll
          for (int i = 0; i < 4; ++i) hp[i] = v[0][i] * rp * gv[i]; }
#pragma unroll
        for (int r = 1; r <= R; ++r) {
            const int row = row0 + r - 1;
            const float rs = rsqrtf(ss[r] * (1.0f / 1024.0f) + 1e-6f);
            const size_t orow = (size_t)row + (row >> 12) + 1;
#pragma unroll
            for (int i = 0; i < 4; ++i) {
                const f32x4 h = v[r][i] * rs * gv[i], xx = hp[i] - h;
                const f32x4 a = h + xx * mr[i], b = h + xx * mk[i], c = h + xx * mv[i];
                hp[i] = h;
                const size_t co = (size_t)i * 256 + lane * 4;
                u32x2 w0; w0.x = cvt_pk_bf16(h[0], h[1]); w0.y = cvt_pk_bf16(h[2], h[3]); *(u32x2*)(hgap + orow * DM + co) = w0;
                u32x2 w1; w1.x = cvt_pk_bf16(a[0], a[1]); w1.y = cvt_pk_bf16(a[2], a[3]); *(u32x2*)(xr + (size_t)row * DM + co) = w1;
                u32x2 w2; w2.x = cvt_pk_bf16(b[0], b[1]); w2.y = cvt_pk_bf16(b[2], b[3]); *(u32x2*)(xk + (size_t)row * DM + co) = w2;
                u32x2 w3; w3.x = cvt_pk_bf16(c[0], c[1]); w3.y = cvt_pk_bf16(c[2], c[3]); *(u32x2*)(xv + (size_t)row * DM + co) = w3;
            }
        }
        if (first) {
            bf16_t* zp = hgap + ((size_t)row0 + (row0 >> 12)) * DM;
#pragma unroll
            for (int i = 0; i < 4; ++i) *(u32x2*)(zp + i * 256 + lane * 4) = (u32x2){0u, 0u};
        }
    }
}

#define MFMA16(a, b, c) __builtin_amdgcn_mfma_f32_16x16x32_bf16((a), (b), (c), 0, 0, 0)
constexpr int KPITCH = 72;
constexpr int VPITCH_SB = 136;
constexpr int VPITCH_DL = 264;

DI void sb_block(const int wv_, const bf16_t* P, bf16_t* merged, LAS unsigned char* lds, int b, int h, int qb) {
    LAS bf16_t* Ks = (LAS bf16_t*)lds;
    LAS bf16_t* Vt = (LAS bf16_t*)(lds + 128 * KPITCH * 2);
    const int tid = my_tid(), w = tid >> 6, lane = tid & 63, fr = lane & 15, fq = lane >> 4;
    const int qpos = qb * 128 + w * 16 + fr;
    const bf16_t* Pb = P + (size_t)b * SEQ * 3072;
    bf16x8 Qf[2];
#pragma unroll
    for (int ks = 0; ks < 2; ++ks) Qf[ks] = *(const bf16x8*)(Pb + (size_t)qpos * 3072 + h * 64 + ks * 32 + fq * 8);
    f32x4 o[4];
#pragma unroll
    for (int dt = 0; dt < 4; ++dt) o[dt] = (f32x4){0.f, 0.f, 0.f, 0.f};
    float carry = 0.f;
    LAS float* cslot = (LAS float*)(lds + 128 * KPITCH * 2 + 64 * VPITCH_SB * 2);
    for (int kb = qb; kb >= 0; --kb) {
        __syncthreads();
        if (kb < qb) {
            float cm = cslot[0];
#pragma unroll
            for (int i = 1; i < 8; ++i) cm = fmaxf(cm, cslot[i]);
            if (cm < -120.0f) break;
        }
#pragma unroll
        for (int i = 0; i < 2; ++i) {
            const int idx = tid + i * 512, key = idx >> 3, seg = idx & 7;
            const bf16_t* src = Pb + (size_t)(kb * 128 + key) * 3072 + h * 64 + seg * 8;
            const u32x4 kv = *(const u32x4*)(src + 256);
            const u32x4 vv = *(const u32x4*)(src + 512);
            *(LAS u32x4*)(Ks + key * KPITCH + seg * 8) = kv;
            LAS bf16_t* vp = Vt + (seg * 8) * VPITCH_SB + key;
            vp[0 * VPITCH_SB] = (bf16_t)(vv.x & 0xffff); vp[1 * VPITCH_SB] = (bf16_t)(vv.x >> 16);
            vp[2 * VPITCH_SB] = (bf16_t)(vv.y & 0xffff); vp[3 * VPITCH_SB] = (bf16_t)(vv.y >> 16);
            vp[4 * VPITCH_SB] = (bf16_t)(vv.z & 0xffff); vp[5 * VPITCH_SB] = (bf16_t)(vv.z >> 16);
            vp[6 * VPITCH_SB] = (bf16_t)(vv.w & 0xffff); vp[7 * VPITCH_SB] = (bf16_t)(vv.w >> 16);
        }
        __syncthreads();
        f32x4 z[8];
#pragma unroll
        for (int kt = 0; kt < 8; ++kt) {
            z[kt] = (f32x4){0.f, 0.f, 0.f, 0.f};
#pragma unroll
            for (int ks = 0; ks < 2; ++ks) { const bf16x8 a = *(const LAS bf16x8*)(Ks + (kt * 16 + fr) * KPITCH + ks * 32 + fq * 8); z[kt] = MFMA16(a, Qf[ks], z[kt]); }
        }
        f32x4 lk[8]; float G[8];
        const int kbase = kb * 128 + 4 * fq;
#pragma unroll
        for (int kt = 0; kt < 8; ++kt) {
            float gs = 0.f;
#pragma unroll
            for (int j = 0; j < 4; ++j) {
                const float zz = z[kt][j] * 0.125f; z[kt][j] = zz;
                const float sp = fmaxf(zz, 0.f) + fast_log(1.0f + fast_exp(-fabsf(zz)));
                const bool valid = (kbase + kt * 16 + j) < qpos;
                const float l = valid ? -sp : 0.f; lk[kt][j] = l; gs += l;
            }
            G[kt] = gs;
        }
        float run = carry;
        bf16x8 Pf[4]; unsigned pw[16];
#pragma unroll
        for (int kt = 7; kt >= 0; --kt) {
            const float g0 = G[kt], b1 = __shfl_xor(g0, 16), c = g0 + b1, d = __shfl_xor(c, 32), tt = c + d;
            const float base = run + ((fq & 1) ? 0.f : b1) + ((fq & 2) ? 0.f : d);
            const float a3 = base, a2 = a3 + lk[kt][3], a1 = a2 + lk[kt][2], a0 = a1 + lk[kt][1];
            const float af[4] = {a0, a1, a2, a3};
            float wv[4];
#pragma unroll
            for (int j = 0; j < 4; ++j) { const bool valid = (kbase + kt * 16 + j) < qpos; wv[j] = valid ? fast_exp(z[kt][j] + lk[kt][j] + af[j]) : 0.f; }
            pw[2 * kt] = cvt_pk_bf16(wv[0], wv[1]); pw[2 * kt + 1] = cvt_pk_bf16(wv[2], wv[3]);
            run += tt;
        }
        carry = run;
        {
            float cm = carry;
            cm = fmaxf(cm, __shfl_xor(cm, 1)); cm = fmaxf(cm, __shfl_xor(cm, 2)); cm = fmaxf(cm, __shfl_xor(cm, 4)); cm = fmaxf(cm, __shfl_xor(cm, 8));
            cm = fmaxf(cm, __shfl_xor(cm, 16)); cm = fmaxf(cm, __shfl_xor(cm, 32));
            if (lane == 0) cslot[w] = cm;
        }
#pragma unroll
        for (int kp = 0; kp < 4; ++kp) { u32x4 pp; pp.x = pw[4 * kp]; pp.y = pw[4 * kp + 1]; pp.z = pw[4 * kp + 2]; pp.w = pw[4 * kp + 3]; Pf[kp] = __builtin_bit_cast(bf16x8, pp); }
#pragma unroll
        for (int dt = 0; dt < 4; ++dt)
#pragma unroll
            for (int kp = 0; kp < 4; ++kp) {
                const LAS bf16_t* vr = Vt + (dt * 16 + fr) * VPITCH_SB + 32 * kp + 4 * fq;
                const s16x4 lo = *(const LAS s16x4*)vr, hi = *(const LAS s16x4*)(vr + 16);
                const bf16x8 a = __builtin_shufflevector(lo, hi, 0, 1, 2, 3, 4, 5, 6, 7);
                o[dt] = MFMA16(a, Pf[kp], o[dt]);
            }
    }
    bf16_t* op = merged + ((size_t)b * SEQ + qpos) * 512 + h * 64 + 4 * fq;
#pragma unroll
    for (int dt = 0; dt < 4; ++dt) { u32x2 wv; wv.x = cvt_pk_bf16(o[dt][0], o[dt][1]); wv.y = cvt_pk_bf16(o[dt][2], o[dt][3]); *(u32x2*)(op + dt * 16) = wv; }
}

DI int t5_bucket(int dist) {
    if (dist < 16) return dist;
    const float d = (float)dist;
    int large = 16 + (int)(logf(d / 16.0f) / 4.852030263919617f * 16.0f);
    return large < 31 ? large : 31;
}

DI void dil_block(const int wv_, const bf16_t* P, bf16_t* og, float* lse, const float* rel_bias, const float* qn, const float* kn, LAS unsigned char* lds, int b, int g, int j, int c, int n) {
    LAS bf16_t* Ks = (LAS bf16_t*)lds;
    LAS bf16_t* Vt = (LAS bf16_t*)(lds + 256 * KPITCH * 2);
    LAS float* biasv = (LAS float*)(lds + 256 * KPITCH * 2 + 64 * VPITCH_DL * 2);
    const int tid = my_tid(), w = tid >> 6, lane = tid & 63, fr = lane & 15, fq = lane >> 4;
    const int r = (g == 0) ? 1 : (g == 1 ? 4 : 16);
    const int hd = 4 * g + j;
    const bf16_t* Pb = P + (size_t)b * SEQ * 3072;
    __syncthreads();
#pragma unroll
    for (int i = 0; i < 4; ++i) {
        const int idx = tid + i * 512, key = idx >> 3, seg = idx & 7;
        const int m = 128 * (n - 1) + key;
        u32x4 kv = (u32x4){0u, 0u, 0u, 0u}, vv = kv;
        if (m >= 0) { const bf16_t* src = Pb + (size_t)(m * r + c) * 3072 + hd * 64 + seg * 8; kv = *(const u32x4*)(src + 1536); vv = *(const u32x4*)(src + 2304); }
        float kf[8] = {bf_lo(kv.x), bf_hi(kv.x), bf_lo(kv.y), bf_hi(kv.y), bf_lo(kv.z), bf_hi(kv.z), bf_lo(kv.w), bf_hi(kv.w)};
        float ss = 0.f;
#pragma unroll
        for (int e = 0; e < 8; ++e) ss += kf[e] * kf[e];
        ss += __shfl_xor(ss, 1); ss += __shfl_xor(ss, 2); ss += __shfl_xor(ss, 4);
        const float rs = rsqrtf(ss * (1.0f / 64.0f) + 1e-6f);
        const f32x4 n0 = *(const f32x4*)(kn + seg * 8), n1 = *(const f32x4*)(kn + seg * 8 + 4);
        u32x4 ko;
        ko.x = cvt_pk_bf16(kf[0] * rs * n0[0], kf[1] * rs * n0[1]); ko.y = cvt_pk_bf16(kf[2] * rs * n0[2], kf[3] * rs * n0[3]);
        ko.z = cvt_pk_bf16(kf[4] * rs * n1[0], kf[5] * rs * n1[1]); ko.w = cvt_pk_bf16(kf[6] * rs * n1[2], kf[7] * rs * n1[3]);
        *(LAS u32x4*)(Ks + key * KPITCH + seg * 8) = ko;
        LAS bf16_t* vp = Vt + (seg * 8) * VPITCH_DL + key;
        vp[0 * VPITCH_DL] = (bf16_t)(vv.x & 0xffff); vp[1 * VPITCH_DL] = (bf16_t)(vv.x >> 16);
        vp[2 * VPITCH_DL] = (bf16_t)(vv.y & 0xffff); vp[3 * VPITCH_DL] = (bf16_t)(vv.y >> 16);
        vp[4 * VPITCH_DL] = (bf16_t)(vv.z & 0xffff); vp[5 * VPITCH_DL] = (bf16_t)(vv.z >> 16);
        vp[6 * VPITCH_DL] = (bf16_t)(vv.w & 0xffff); vp[7 * VPITCH_DL] = (bf16_t)(vv.w >> 16);
    }
    if (tid < 132) { const int dd = tid < 128 ? tid : 128; biasv[tid] = rel_bias[t5_bucket(dd * r) * 12 + hd]; }
    const int qi = w * 16 + fr;
    const int tq = (128 * n + qi) * r + c;
    bf16x8 Qf[2];
    {
        u32x4 qv[2]; float ss = 0.f; float qf[16];
#pragma unroll
        for (int ks = 0; ks < 2; ++ks) { qv[ks] = *(const u32x4*)(Pb + (size_t)tq * 3072 + 768 + hd * 64 + ks * 32 + fq * 8);
            qf[ks * 8 + 0] = bf_lo(qv[ks].x); qf[ks * 8 + 1] = bf_hi(qv[ks].x); qf[ks * 8 + 2] = bf_lo(qv[ks].y); qf[ks * 8 + 3] = bf_hi(qv[ks].y);
            qf[ks * 8 + 4] = bf_lo(qv[ks].z); qf[ks * 8 + 5] = bf_hi(qv[ks].z); qf[ks * 8 + 6] = bf_lo(qv[ks].w); qf[ks * 8 + 7] = bf_hi(qv[ks].w); }
#pragma unroll
        for (int e = 0; e < 16; ++e) ss += qf[e] * qf[e];
        ss += __shfl_xor(ss, 16); ss += __shfl_xor(ss, 32);
        const float rs = rsqrtf(ss * (1.0f / 64.0f) + 1e-6f);
#pragma unroll
        for (int ks = 0; ks < 2; ++ks) {
            const f32x4 n0 = *(const f32x4*)(qn + ks * 32 + fq * 8), n1 = *(const f32x4*)(qn + ks * 32 + fq * 8 + 4);
            u32x4 qo;
            qo.x = cvt_pk_bf16(qf[ks * 8 + 0] * rs * n0[0], qf[ks * 8 + 1] * rs * n0[1]); qo.y = cvt_pk_bf16(qf[ks * 8 + 2] * rs * n0[2], qf[ks * 8 + 3] * rs * n0[3]);
            qo.z = cvt_pk_bf16(qf[ks * 8 + 4] * rs * n1[0], qf[ks * 8 + 5] * rs * n1[1]); qo.w = cvt_pk_bf16(qf[ks * 8 + 6] * rs * n1[2], qf[ks * 8 + 7] * rs * n1[3]);
            Qf[ks] = __builtin_bit_cast(bf16x8, qo);
        }
    }
    __syncthreads();
    f32x4 s[9];
#pragma unroll
    for (int kt = 0; kt < 9; ++kt) {
        s[kt] = (f32x4){0.f, 0.f, 0.f, 0.f};
#pragma unroll
        for (int ks = 0; ks < 2; ++ks) { const bf16x8 a = *(const LAS bf16x8*)(Ks + ((w + kt) * 16 + fr) * KPITCH + ks * 32 + fq * 8); s[kt] = MFMA16(a, Qf[ks], s[kt]); }
    }
    float mx = -1e30f;
#pragma unroll
    for (int kt = 0; kt < 9; ++kt)
#pragma unroll
        for (int jj = 0; jj < 4; ++jj) {
            const int key = 16 * (w + kt) + 4 * fq + jj, kj = key - 128, dist = qi - kj;
            const bool valid = (dist >= 0) && (dist <= 128) && (n > 0 || kj >= 0);
            const int di = dist < 0 ? 0 : (dist > 128 ? 128 : dist);
            const float v = valid ? (s[kt][jj] * 0.125f + biasv[di]) : -1e30f;
            s[kt][jj] = v; mx = fmaxf(mx, v);
        }
    mx = fmaxf(mx, __shfl_xor(mx, 16)); mx = fmaxf(mx, __shfl_xor(mx, 32));
    float den = 0.f;
    bf16x8 Pf[5]; unsigned pw[20];
#pragma unroll
    for (int kt = 0; kt < 9; ++kt) {
        float pv[4];
#pragma unroll
        for (int jj = 0; jj < 4; ++jj) { const float v = s[kt][jj]; const float p = (v > -1e29f) ? fast_exp(v - mx) : 0.f; pv[jj] = p; den += p; }
        pw[2 * kt] = cvt_pk_bf16(pv[0], pv[1]); pw[2 * kt + 1] = cvt_pk_bf16(pv[2], pv[3]);
    }
    pw[18] = 0u; pw[19] = 0u;
#pragma unroll
    for (int kp = 0; kp < 5; ++kp) { u32x4 pp; pp.x = pw[4 * kp]; pp.y = pw[4 * kp + 1]; pp.z = pw[4 * kp + 2]; pp.w = pw[4 * kp + 3]; Pf[kp] = __builtin_bit_cast(bf16x8, pp); }
    den += __shfl_xor(den, 16); den += __shfl_xor(den, 32);
    f32x4 o[4];
#pragma unroll
    for (int dt = 0; dt < 4; ++dt) {
        o[dt] = (f32x4){0.f, 0.f, 0.f, 0.f};
#pragma unroll
        for (int kp = 0; kp < 5; ++kp) {
            const LAS bf16_t* vr = Vt + (dt * 16 + fr) * VPITCH_DL + 16 * (w + 2 * kp) + 4 * fq;
            const s16x4 lo = *(const LAS s16x4*)vr;
            s16x4 hi = (s16x4){0, 0, 0, 0};
            if (kp < 4) hi = *(const LAS s16x4*)(vr + 16);
            const bf16x8 a = __builtin_shufflevector(lo, hi, 0, 1, 2, 3, 4, 5, 6, 7);
            o[dt] = MFMA16(a, Pf[kp], o[dt]);
        }
    }
    const float inv = 1.0f / den;
    const size_t tok = (size_t)b * SEQ + tq;
    bf16_t* op = og + ((size_t)g * T_TOK + tok) * 256 + j * 64 + 4 * fq;
#pragma unroll
    for (int dt = 0; dt < 4; ++dt) { u32x2 wv; wv.x = cvt_pk_bf16(o[dt][0] * inv, o[dt][1] * inv); wv.y = cvt_pk_bf16(o[dt][2] * inv, o[dt][3] * inv); *(u32x2*)(op + dt * 16) = wv; }
    if (fq == 0) lse[((size_t)g * T_TOK + tok) * 4 + j] = mx + logf(den);
}

DI void attn_phase(const int wv_, const bf16_t* P, bf16_t* merged, bf16_t* og, float* lse, const float* rel_bias, const float* qn, const float* kn, LAS unsigned char* lds) {
    for (int it = my_bid(); it < 512; it += my_nblk()) {
        const int bh = it >> 4, pr = it & 15, b = bh >> 2, h = bh & 3;
        sb_block(wv_, P, merged, lds, b, h, 31 - pr);
        sb_block(wv_, P, merged, lds, b, h, pr);
    }
    for (int it = my_bid(); it < 3072; it += my_nblk()) {
        const int sbk = it & 31, j = (it >> 5) & 3, gb = it >> 7, g = gb % 3, b = gb / 3;
        const int r = (g == 0) ? 1 : (g == 1 ? 4 : 16);
        const int c = sbk % r, n = sbk / r;
        dil_block(wv_, P, og, lse, rel_bias, qn, kn, lds, b, g, j, c, n);
    }
}

DI void combine_phase(const int wv_, const bf16_t* og, const float* lse, bf16_t* merged) {
    const int nthr = my_nblk() * 512;
    for (int i = my_bid() * 512 + my_tid(); i < T_TOK * 32; i += nthr) {
        const int tok = i >> 5, j = (i >> 3) & 3, seg = i & 7;
        const float l0 = lse[(size_t)tok * 4 + j], l1 = lse[((size_t)T_TOK + tok) * 4 + j], l2 = lse[((size_t)2 * T_TOK + tok) * 4 + j];
        const float m = fmaxf(l0, fmaxf(l1, l2));
        float a0 = __expf(l0 - m), a1 = __expf(l1 - m), a2 = __expf(l2 - m);
        const float inv = 1.0f / (a0 + a1 + a2); a0 *= inv; a1 *= inv; a2 *= inv;
        const size_t off = (size_t)tok * 256 + j * 64 + seg * 8;
        const u32x4 x0 = *(const u32x4*)(og + off), x1 = *(const u32x4*)(og + (size_t)T_TOK * 256 + off), x2 = *(const u32x4*)(og + (size_t)2 * T_TOK * 256 + off);
        u32x4 r;
        r.x = cvt_pk_bf16(a0 * bf_lo(x0.x) + a1 * bf_lo(x1.x) + a2 * bf_lo(x2.x), a0 * bf_hi(x0.x) + a1 * bf_hi(x1.x) + a2 * bf_hi(x2.x));
        r.y = cvt_pk_bf16(a0 * bf_lo(x0.y) + a1 * bf_lo(x1.y) + a2 * bf_lo(x2.y), a0 * bf_hi(x0.y) + a1 * bf_hi(x1.y) + a2 * bf_hi(x2.y));
        r.z = cvt_pk_bf16(a0 * bf_lo(x0.z) + a1 * bf_lo(x1.z) + a2 * bf_lo(x2.z), a0 * bf_hi(x0.z) + a1 * bf_hi(x1.z) + a2 * bf_hi(x2.z));
        r.w = cvt_pk_bf16(a0 * bf_lo(x0.w) + a1 * bf_lo(x1.w) + a2 * bf_lo(x2.w), a0 * bf_hi(x0.w) + a1 * bf_hi(x1.w) + a2 * bf_hi(x2.w));
        *(u32x4*)(merged + (size_t)tok * 512 + 256 + j * 64 + seg * 8) = r;
    }
}

DI float dpp_sum16(float x) {
    x += __int_as_float(__builtin_amdgcn_update_dpp(0, __float_as_int(x), 0xB1, 0xf, 0xf, false));
    x += __int_as_float(__builtin_amdgcn_update_dpp(0, __float_as_int(x), 0x4E, 0xf, 0xf, false));
    x += __int_as_float(__builtin_amdgcn_update_dpp(0, __float_as_int(x), 0x124, 0xf, 0xf, false));
    x += __int_as_float(__builtin_amdgcn_update_dpp(0, __float_as_int(x), 0x128, 0xf, 0xf, false));
    return x;
}
constexpr int SC_STEP = 356;
constexpr int SC_CH = 32;
constexpr int SC_BUF = SC_CH * SC_STEP;

DI void scan_item(const int wv_, const bf16_t* Rg, const bf16_t* Kg, const bf16_t* Vg, const bf16_t* OMg, const bf16_t* Ag, bf16_t* Yg, float* bon,
                  const float* k_k, const float* k_a, const float* r_k, LAS unsigned char* lds, int b, int h, int half) {
    LAS float* buf = (LAS float*)lds;
    LAS float* ybuf = (LAS float*)(lds + 2 * SC_BUF * 4);
    const int tid = my_tid(), w = tid >> 6, lane = tid & 63, kq = lane & 15, rho = lane >> 4;
    const int st = tid >> 4, part = tid & 15;
    const int pc = part < 8 ? part : 0;
    float pkk[8], pka[8], prk[8];
#pragma unroll
    for (int e = 0; e < 8; ++e) { pkk[e] = k_k[h * 64 + pc * 8 + e]; pka[e] = k_a[h * 64 + pc * 8 + e]; prk[e] = r_k[h * 64 + pc * 8 + e]; }
    const size_t tok0 = (size_t)b * SEQ;
    u32x4 g_r, g_k, g_om, g_a;
    auto issue = [&](int chunk) __attribute__((always_inline)) {
        const size_t t = tok0 + chunk * SC_CH + st;
        const size_t o = t * DM + h * 64 + pc * 8;
        const bf16_t* p0 = (part < 8) ? (Rg + o) : (Vg + t * DM + h * 64 + half * 32 + (part & 3) * 8);
        g_r = *(const u32x4*)p0; g_k = *(const u32x4*)(Kg + o); g_om = *(const u32x4*)(OMg + o); g_a = *(const u32x4*)(Ag + o);
    };
    auto commit = [&](int chunk, LAS float* dst) __attribute__((always_inline)) {
        LAS float* sp = dst + st * SC_STEP;
        float kf[8], af[8], rf[8], of[8];
        const unsigned kw[4] = {g_k.x, g_k.y, g_k.z, g_k.w}, aw[4] = {g_a.x, g_a.y, g_a.z, g_a.w}, rw[4] = {g_r.x, g_r.y, g_r.z, g_r.w}, ow[4] = {g_om.x, g_om.y, g_om.z, g_om.w};
#pragma unroll
        for (int q = 0; q < 4; ++q) {
            kf[2 * q] = bf_lo(kw[q]); kf[2 * q + 1] = bf_hi(kw[q]); af[2 * q] = bf_lo(aw[q]); af[2 * q + 1] = bf_hi(aw[q]); rf[2 * q] = bf_lo(rw[q]); rf[2 * q + 1] = bf_hi(rw[q]);
            const h16x2 hh = __builtin_bit_cast(h16x2, ow[q]); of[2 * q] = (float)hh.x; of[2 * q + 1] = (float)hh.y;
        }
        float kkv[8], ss = 0.f;
#pragma unroll
        for (int e = 0; e < 8; ++e) { kkv[e] = kf[e] * pkk[e]; ss += kkv[e] * kkv[e]; }
        ss += __shfl_xor(ss, 1); ss += __shfl_xor(ss, 2); ss += __shfl_xor(ss, 4);
        const float inv = 1.0f / fmaxf(sqrtf(ss), 1e-12f);
        float Wv[8], Kv[8], Av[8], Bv[8], Qv[8], bo = 0.f, br = 0.f, kr = 0.f;
#pragma unroll
        for (int e = 0; e < 8; ++e) {
            const float kk = kkv[e] * inv;
            Av[e] = -kk; Bv[e] = kk * af[e]; Kv[e] = kf[e] * (1.0f + (af[e] - 1.0f) * pka[e]); Wv[e] = 1.0f - of[e]; Qv[e] = Wv[e] * rf[e];
            bo += rf[e] * Kv[e] * prk[e]; br += Bv[e] * rf[e]; kr += Kv[e] * rf[e];
        }
        bo += __shfl_xor(bo, 1); bo += __shfl_xor(bo, 2); bo += __shfl_xor(bo, 4);
        br += __shfl_xor(br, 1); br += __shfl_xor(br, 2); br += __shfl_xor(br, 4);
        kr += __shfl_xor(kr, 1); kr += __shfl_xor(kr, 2); kr += __shfl_xor(kr, 4);
        if (part < 8) {
            *(LAS f32x4*)(sp + 0 * 64 + part * 8) = (f32x4){Wv[0], Wv[1], Wv[2], Wv[3]}; *(LAS f32x4*)(sp + 0 * 64 + part * 8 + 4) = (f32x4){Wv[4], Wv[5], Wv[6], Wv[7]};
            *(LAS f32x4*)(sp + 1 * 64 + part * 8) = (f32x4){Kv[0], Kv[1], Kv[2], Kv[3]}; *(LAS f32x4*)(sp + 1 * 64 + part * 8 + 4) = (f32x4){Kv[4], Kv[5], Kv[6], Kv[7]};
            *(LAS f32x4*)(sp + 2 * 64 + part * 8) = (f32x4){Av[0], Av[1], Av[2], Av[3]}; *(LAS f32x4*)(sp + 2 * 64 + part * 8 + 4) = (f32x4){Av[4], Av[5], Av[6], Av[7]};
            *(LAS f32x4*)(sp + 3 * 64 + part * 8) = (f32x4){Bv[0], Bv[1], Bv[2], Bv[3]}; *(LAS f32x4*)(sp + 3 * 64 + part * 8 + 4) = (f32x4){Bv[4], Bv[5], Bv[6], Bv[7]};
            *(LAS f32x4*)(sp + 4 * 64 + part * 8) = (f32x4){Qv[0], Qv[1], Qv[2], Qv[3]}; *(LAS f32x4*)(sp + 4 * 64 + part * 8 + 4) = (f32x4){Qv[4], Qv[5], Qv[6], Qv[7]};
            if (part == 0) *(LAS f32x2*)(sp + 352) = (f32x2){br, kr};
            if (part == 0 && half == 0) bon[(tok0 + chunk * SC_CH + st) * 16 + h] = bo;
        } else if (part < 12) {
            const unsigned vw[4] = {g_r.x, g_r.y, g_r.z, g_r.w};
            *(LAS f32x4*)(sp + 320 + (part - 8) * 8) = (f32x4){bf_lo(vw[0]), bf_hi(vw[0]), bf_lo(vw[1]), bf_hi(vw[1])};
            *(LAS f32x4*)(sp + 320 + (part - 8) * 8 + 4) = (f32x4){bf_lo(vw[2]), bf_hi(vw[2]), bf_lo(vw[3]), bf_hi(vw[3])};
        }
    };
    auto flush = [&](int chunk) __attribute__((always_inline)) {
        if (part < 4) {
            const LAS float* yp = ybuf + (chunk & 1) * 1024 + st * 32 + part * 8;
            const f32x4 y0 = *(const LAS f32x4*)yp, y1 = *(const LAS f32x4*)(yp + 4);
            u32x4 o; o.x = cvt_pk_bf16(y0[0], y0[1]); o.y = cvt_pk_bf16(y0[2], y0[3]); o.z = cvt_pk_bf16(y1[0], y1[1]); o.w = cvt_pk_bf16(y1[2], y1[3]);
            *(u32x4*)(Yg + (tok0 + chunk * SC_CH + st) * DM + h * 64 + half * 32 + part * 8) = o;
        }
    };
    f32x2 S0 = (f32x2){0.f, 0.f}, S1 = (f32x2){0.f, 0.f};
    const int tid_ = tid;
    auto steps = [&](const LAS float* src, LAS float* yb, int ysel, int s0, int s1) __attribute__((always_inline)) {
        const LAS float* sp0 = src + 4 * kq; const LAS float* vp0 = src + 320 + 4 * w + rho;
        f32x4 w4 = *(const LAS f32x4*)(sp0 + s0 * SC_STEP), k4 = *(const LAS f32x4*)(sp0 + s0 * SC_STEP + 64), a4 = *(const LAS f32x4*)(sp0 + s0 * SC_STEP + 128),
              b4 = *(const LAS f32x4*)(sp0 + s0 * SC_STEP + 192), q4 = *(const LAS f32x4*)(sp0 + s0 * SC_STEP + 256);
        float vr = vp0[s0 * SC_STEP]; f32x2 bk = *(const LAS f32x2*)(src + s0 * SC_STEP + 352);
#pragma unroll 4
        for (int s = s0; s < s1; ++s) {
            const int sn = (s + 1 < SC_CH) ? s + 1 : s;
            const f32x4 nw4 = *(const LAS f32x4*)(sp0 + sn * SC_STEP), nk4 = *(const LAS f32x4*)(sp0 + sn * SC_STEP + 64), na4 = *(const LAS f32x4*)(sp0 + sn * SC_STEP + 128),
                        nb4 = *(const LAS f32x4*)(sp0 + sn * SC_STEP + 192), nq4 = *(const LAS f32x4*)(sp0 + sn * SC_STEP + 256);
            const float nvr = vp0[sn * SC_STEP]; const f32x2 nbk = *(const LAS f32x2*)(src + sn * SC_STEP + 352);
            const f32x2 a0 = {a4[0], a4[1]}, a1 = {a4[2], a4[3]}, q0 = {q4[0], q4[1]}, q1 = {q4[2], q4[3]};
            const f32x2 t1 = S0 * a0 + S1 * a1, t2 = S0 * q0 + S1 * q1;
            float p1 = t1[0] + t1[1], p2 = t2[0] + t2[1];
            p1 += __int_as_float(__builtin_amdgcn_update_dpp(0, __float_as_int(p1), 0xB1, 0xf, 0xf, false));
            p2 += __int_as_float(__builtin_amdgcn_update_dpp(0, __float_as_int(p2), 0xB1, 0xf, 0xf, false));
            p1 += __int_as_float(__builtin_amdgcn_update_dpp(0, __float_as_int(p1), 0x4E, 0xf, 0xf, false));
            p2 += __int_as_float(__builtin_amdgcn_update_dpp(0, __float_as_int(p2), 0x4E, 0xf, 0xf, false));
            p1 += __int_as_float(__builtin_amdgcn_update_dpp(0, __float_as_int(p1), 0x124, 0xf, 0xf, false));
            p2 += __int_as_float(__builtin_amdgcn_update_dpp(0, __float_as_int(p2), 0x124, 0xf, 0xf, false));
            p1 += __int_as_float(__builtin_amdgcn_update_dpp(0, __float_as_int(p1), 0x128, 0xf, 0xf, false));
            p2 += __int_as_float(__builtin_amdgcn_update_dpp(0, __float_as_int(p2), 0x128, 0xf, 0xf, false));
            const float sa = p1;
            const float y = p2 + sa * bk[0] + vr * bk[1];
            const f32x2 sa2 = {sa, sa}, vr2 = {vr, vr};
            const f32x2 w0 = {w4[0], w4[1]}, w1 = {w4[2], w4[3]}, b0 = {b4[0], b4[1]}, b1 = {b4[2], b4[3]}, k0 = {k4[0], k4[1]}, k1 = {k4[2], k4[3]};
            S0 = S0 * w0 + b0 * sa2 + k0 * vr2;
            S1 = S1 * w1 + b1 * sa2 + k1 * vr2;
            yb[ysel + s * 32] = y;
            w4 = nw4; k4 = nk4; a4 = na4; b4 = nb4; q4 = nq4; vr = nvr; bk = nbk;
        }
    };
    __syncthreads();
    issue(0); commit(0, buf);
    __syncthreads();
    constexpr int NCH = SEQ / SC_CH;
    for (int c = 0; c < NCH; ++c) {
        LAS float* cur = buf + (c & 1) * SC_BUF; LAS float* nxt = buf + ((c + 1) & 1) * SC_BUF; LAS float* yb = ybuf + (c & 1) * 1024;
        const int ysel = (kq == 0) ? (4 * w + rho) : (2048 - (c & 1) * 1024 + tid_);
        if (c + 1 < NCH) issue(c + 1);
        if (c > 0) flush(c - 1);
        steps(cur, yb, ysel, 0, SC_CH / 2);
        if (c + 1 < NCH) commit(c + 1, nxt);
        steps(cur, yb, ysel, SC_CH / 2, SC_CH);
        __syncthreads();
    }
    flush(NCH - 1);
}

constexpr int C2_AT = 0, C2_RT = 2304, C2_BT = 4608, C2_KT = 6912, C2_BK = 9216, C2_VT = 14336, C2_MK = 16384, C2_NR = 16896, C2_MR = 17408, C2_TT = 17920,
              C2_NF = 18432, C2_GC = 19456, C2_SLOT = 19712, C2_NBUF = 7, C2_NHELP = 6, C2_FLAGS = C2_SLOT * C2_NBUF;
DI float wave_sum64(float x) {
    x = dpp_sum16(x);
    const int xi = __float_as_int(x);
    const float s0 = __int_as_float(__builtin_amdgcn_readlane(xi, 0)), s1 = __int_as_float(__builtin_amdgcn_readlane(xi, 16)),
                s2 = __int_as_float(__builtin_amdgcn_readlane(xi, 32)), s3 = __int_as_float(__builtin_amdgcn_readlane(xi, 48));
    return (s0 + s1) + (s2 + s3);
}
DI unsigned short f2bf(float x) { return (unsigned short)(cvt_pk_bf16(x, 0.f) & 0xffffu); }
DI float bf2f(unsigned short u) { return __uint_as_float((unsigned)u << 16); }

DI void scan2_item(const int wv_, const bf16_t* Rg, const bf16_t* Kg, const bf16_t* Vg, const bf16_t* OMg, const bf16_t* Ag, bf16_t* Yg, float* bon,
                   const float* k_k, const float* k_a, const float* r_k, LAS unsigned char* lds, int b, int h) {
    const int tid = my_tid(), w = tid >> 6, lane = tid & 63, fr = lane & 15, fq = lane >> 4;
    LAS unsigned* flags = (LAS unsigned*)(lds + C2_FLAGS);
    const size_t tok0 = (size_t)b * SEQ;
    constexpr int NCH = SEQ / 16;
    __syncthreads();
    if (tid < 16) flags[tid] = 0u;
    __syncthreads();
    if (w >= 2) {
        const int c = lane;
        const float pkk = k_k[h * 64 + c], pka = k_a[h * 64 + c], prk = r_k[h * 64 + c];
        typedef unsigned short u16x2 __attribute__((ext_vector_type(2)));
        u16x2 nrk[16], noa[16]; unsigned short nvr[16];
        {
            const size_t base0 = (tok0 + (size_t)(w - 2) * 16) * DM + h * 64 + c;
#pragma unroll
            for (int t = 0; t < 16; ++t) { nrk[t].x = Rg[base0 + (size_t)t * DM]; nrk[t].y = Kg[base0 + (size_t)t * DM]; noa[t].x = OMg[base0 + (size_t)t * DM]; noa[t].y = Ag[base0 + (size_t)t * DM]; nvr[t] = Vg[base0 + (size_t)t * DM]; }
        }
        for (int ch = w - 2; ch < NCH; ch += C2_NHELP) {
            LAS unsigned char* slot = lds + (ch % C2_NBUF) * C2_SLOT;
            unsigned short rr[16], kr[16], orr[16], ar[16], vr[16];
#pragma unroll
            for (int t = 0; t < 16; ++t) { rr[t] = nrk[t].x; kr[t] = nrk[t].y; orr[t] = noa[t].x; ar[t] = noa[t].y; vr[t] = nvr[t]; }
            {
                const int chn = (ch + C2_NHELP < NCH) ? ch + C2_NHELP : ch;
                const size_t base = (tok0 + (size_t)chn * 16) * DM + h * 64 + c;
#pragma unroll
                for (int t = 0; t < 16; ++t) { nrk[t].x = Rg[base + (size_t)t * DM]; nrk[t].y = Kg[base + (size_t)t * DM]; noa[t].x = OMg[base + (size_t)t * DM]; noa[t].y = Ag[base + (size_t)t * DM]; nvr[t] = Vg[base + (size_t)t * DM]; }
            }
            if (ch >= C2_NBUF) {
                const unsigned need = (unsigned)(ch - C2_NBUF + 1);
                for (;;) {
                    const unsigned d0 = *(volatile LAS unsigned*)(flags + 8), d1 = *(volatile LAS unsigned*)(flags + 9);
                    if (d0 >= need && d1 >= need) break;
                    __builtin_amdgcn_s_sleep(1);
                }
                asm volatile("" ::: "memory");
            }
            LAS bf16_t* AT = (LAS bf16_t*)(slot + C2_AT); LAS bf16_t* RT = (LAS bf16_t*)(slot + C2_RT); LAS bf16_t* BT = (LAS bf16_t*)(slot + C2_BT); LAS bf16_t* KT = (LAS bf16_t*)(slot + C2_KT);
#pragma unroll
            for (int t = 0; t < 16; ++t) {
                const float kf = bf2f(kr[t]), af = bf2f(ar[t]), rf = bf2f(rr[t]);
                BT[t * 72 + c] = f2bf(kf * pkk); KT[t * 72 + c] = f2bf(kf * (1.0f + (af - 1.0f) * pka)); AT[t * 72 + c] = f2bf(rf * prk);
            }
            asm volatile("s_waitcnt lgkmcnt(0)" ::: "memory");
            {
                f32x4 g1 = {0.f, 0.f, 0.f, 0.f}, g2 = g1;
#pragma unroll
                for (int ks = 0; ks < 2; ++ks) {
                    const bf16x8 fB = *(const LAS bf16x8*)(BT + fr * 72 + ks * 32 + fq * 8), fK = *(const LAS bf16x8*)(KT + fr * 72 + ks * 32 + fq * 8), fA = *(const LAS bf16x8*)(AT + fr * 72 + ks * 32 + fq * 8);
                    g1 = MFMA16(fB, fB, g1); g2 = MFMA16(fK, fA, g2);
                }
                const int sel = fr & 3;
                const float ss = sel == 0 ? g1[0] : (sel == 1 ? g1[1] : (sel == 2 ? g1[2] : g1[3]));
                const float bo = sel == 0 ? g2[0] : (sel == 1 ? g2[1] : (sel == 2 ? g2[2] : g2[3]));
                if (fq == (fr >> 2)) {
                    *(LAS float*)(slot + C2_NF + fr * 4) = 1.0f / fmaxf(sqrtf(ss), 1e-12f);
                    bon[(tok0 + (size_t)ch * 16 + fr) * 16 + h] = bo;
                }
            }
            asm volatile("s_waitcnt lgkmcnt(0)" ::: "memory");
            float inv[16];
            {
                const LAS f32x4* ip = (const LAS f32x4*)(slot + C2_NF);
                const f32x4 i0 = ip[0], i1 = ip[1], i2 = ip[2], i3 = ip[3];
                const float tmp[16] = {i0[0], i0[1], i0[2], i0[3], i1[0], i1[1], i1[2], i1[3], i2[0], i2[1], i2[2], i2[3], i3[0], i3[1], i3[2], i3[3]};
#pragma unroll
                for (int t = 0; t < 16; ++t) inv[t] = tmp[t];
            }
            asm volatile("s_waitcnt lgkmcnt(0)" ::: "memory");
            float G = 1.0f; float bh[16], kh[16];
#pragma unroll
            for (int t = 0; t < 16; ++t) {
                const float kf = bf2f(kr[t]), af = bf2f(ar[t]), rf = bf2f(rr[t]);
                const float om = (float)__builtin_bit_cast(_Float16, orr[t]);
                const float kk = kf * pkk * inv[t];
                const float kp = kf * (1.0f + (af - 1.0f) * pka);
                const float wt = 1.0f - om;
                const float Gp = G; G *= wt;
                const float ig = fast_rcp(G);
                AT[t * 72 + c] = f2bf(-kk * Gp); RT[t * 72 + c] = f2bf(rf * G);
                bh[t] = kk * af * ig; kh[t] = kp * ig;
                BT[t * 72 + c] = f2bf(bh[t]); KT[t * 72 + c] = f2bf(kh[t]);
            }
            *(LAS float*)(slot + C2_GC + c * 4) = G;
#pragma unroll
            for (int q = 0; q < 4; ++q) {
                u32x4 wv4; wv4.x = cvt_pk_bf16(bh[4 * q] * G, bh[4 * q + 1] * G); wv4.y = cvt_pk_bf16(bh[4 * q + 2] * G, bh[4 * q + 3] * G);
                wv4.z = cvt_pk_bf16(kh[4 * q] * G, kh[4 * q + 1] * G); wv4.w = cvt_pk_bf16(kh[4 * q + 2] * G, kh[4 * q + 3] * G);
                *(LAS u32x4*)(slot + C2_BK + c * 80 + q * 16) = wv4;
            }
#pragma unroll
            for (int q = 0; q < 2; ++q) {
                u32x4 wv4; wv4.x = (unsigned)vr[8 * q] | ((unsigned)vr[8 * q + 1] << 16); wv4.y = (unsigned)vr[8 * q + 2] | ((unsigned)vr[8 * q + 3] << 16);
                wv4.z = (unsigned)vr[8 * q + 4] | ((unsigned)vr[8 * q + 5] << 16); wv4.w = (unsigned)vr[8 * q + 6] | ((unsigned)vr[8 * q + 7] << 16);
                *(LAS u32x4*)(slot + C2_VT + c * 32 + q * 16) = wv4;
            }
            asm volatile("s_waitcnt lgkmcnt(0)" ::: "memory");
            f32x4 cN = {0.f, 0.f, 0.f, 0.f}, cMk = cN, cNr = cN, cMr = cN;
#pragma unroll
            for (int ks = 0; ks < 2; ++ks) {
                const bf16x8 fB = *(const LAS bf16x8*)(BT + fr * 72 + ks * 32 + fq * 8), fK = *(const LAS bf16x8*)(KT + fr * 72 + ks * 32 + fq * 8);
                const bf16x8 fA = *(const LAS bf16x8*)(AT + fr * 72 + ks * 32 + fq * 8), fR = *(const LAS bf16x8*)(RT + fr * 72 + ks * 32 + fq * 8);
                cN = MFMA16(fB, fA, cN); cMk = MFMA16(fK, fA, cMk); cNr = MFMA16(fB, fR, cNr); cMr = MFMA16(fK, fR, cMr);
            }
#pragma unroll
            for (int jj = 0; jj < 4; ++jj) { const int j = 4 * fq + jj; if (!(j < fr)) { cN[jj] = 0.f; cMk[jj] = 0.f; } if (!(j <= fr)) { cNr[jj] = 0.f; cMr[jj] = 0.f; } }
            *(LAS f32x4*)(slot + C2_NF + (fr * 16 + 4 * fq) * 4) = cN;
            { u32x2 o; o.x = cvt_pk_bf16(cMk[0], cMk[1]); o.y = cvt_pk_bf16(cMk[2], cMk[3]); *(LAS u32x2*)(slot + C2_MK + (fr * 16 + 4 * fq) * 2) = o; }
            { u32x2 o; o.x = cvt_pk_bf16(cNr[0], cNr[1]); o.y = cvt_pk_bf16(cNr[2], cNr[3]); *(LAS u32x2*)(slot + C2_NR + (fr * 16 + 4 * fq) * 2) = o; }
            { u32x2 o; o.x = cvt_pk_bf16(cMr[0], cMr[1]); o.y = cvt_pk_bf16(cMr[2], cMr[3]); *(LAS u32x2*)(slot + C2_MR + (fr * 16 + 4 * fq) * 2) = o; }
            asm volatile("s_waitcnt lgkmcnt(0)" ::: "memory");
            float Tr[16];
#pragma unroll
            for (int t = 0; t < 16; ++t) {
                const LAS f32x4* nrow = (const LAS f32x4*)(slot + C2_NF + t * 64);
                const f32x4 n0 = nrow[0], n1 = nrow[1], n2 = nrow[2], n3 = nrow[3];
                const float nn[16] = {n0[0], n0[1], n0[2], n0[3], n1[0], n1[1], n1[2], n1[3], n2[0], n2[1], n2[2], n2[3], n3[0], n3[1], n3[2], n3[3]};
                float v0 = (fr == t) ? 1.0f : 0.0f, v1 = 0.f;
#pragma unroll
                for (int j = 0; j < t; ++j) { if (j & 1) v1 += Tr[j] * nn[j]; else v0 += Tr[j] * nn[j]; }
                Tr[t] = v0 + v1;
            }
            if (fq == 0) {
#pragma unroll
                for (int t = 0; t < 16; ++t) ((LAS bf16_t*)(slot + C2_TT))[t * 16 + fr] = f2bf(Tr[t]);
            }
            asm volatile("s_waitcnt lgkmcnt(0)" ::: "memory");
            if (lane == 0) *(volatile LAS unsigned*)(flags + (ch % C2_NBUF)) = (unsigned)(ch + 1);
        }
    } else {
        f32x4 acc[2][4];
#pragma unroll
        for (int i = 0; i < 2; ++i)
#pragma unroll
            for (int kt = 0; kt < 4; ++kt) acc[i][kt] = (f32x4){0.f, 0.f, 0.f, 0.f};
        const s16x4 z4 = {0, 0, 0, 0};
        for (int ch = 0; ch < NCH; ++ch) {
            LAS unsigned char* slot = lds + (ch % C2_NBUF) * C2_SLOT;
            while (*(volatile LAS unsigned*)(flags + (ch % C2_NBUF)) != (unsigned)(ch + 1)) __builtin_amdgcn_s_sleep(1);
            asm volatile("" ::: "memory");
            const LAS bf16_t* AT = (const LAS bf16_t*)(slot + C2_AT); const LAS bf16_t* RT = (const LAS bf16_t*)(slot + C2_RT);
            bf16x8 fa[2], fr2[2];
#pragma unroll
            for (int kp = 0; kp < 2; ++kp) {
                const s16x4 a0 = *(const LAS s16x4*)(AT + fr * 72 + 32 * kp + 4 * fq), a1 = *(const LAS s16x4*)(AT + fr * 72 + 32 * kp + 16 + 4 * fq);
                const s16x4 r0 = *(const LAS s16x4*)(RT + fr * 72 + 32 * kp + 4 * fq), r1 = *(const LAS s16x4*)(RT + fr * 72 + 32 * kp + 16 + 4 * fq);
                fa[kp] = __builtin_shufflevector(a0, a1, 0, 1, 2, 3, 4, 5, 6, 7); fr2[kp] = __builtin_shufflevector(r0, r1, 0, 1, 2, 3, 4, 5, 6, 7);
            }
            const s16x4 mk = *(const LAS s16x4*)(slot + C2_MK + (fr * 16 + 4 * fq) * 2), tt = *(const LAS s16x4*)(slot + C2_TT + (fr * 16 + 4 * fq) * 2);
            const s16x4 nr = *(const LAS s16x4*)(slot + C2_NR + (fr * 16 + 4 * fq) * 2), mr = *(const LAS s16x4*)(slot + C2_MR + (fr * 16 + 4 * fq) * 2);
            const bf16x8 fmk = __builtin_shufflevector(z4, mk, 0, 1, 2, 3, 4, 5, 6, 7), ftt = __builtin_shufflevector(tt, z4, 0, 1, 2, 3, 4, 5, 6, 7), fnm = __builtin_shufflevector(nr, mr, 0, 1, 2, 3, 4, 5, 6, 7);
            f32x4 g4[4]; bf16x8 bk[4];
#pragma unroll
            for (int kt = 0; kt < 4; ++kt) { g4[kt] = *(const LAS f32x4*)(slot + C2_GC + (16 * kt + 4 * fq) * 4); bk[kt] = *(const LAS bf16x8*)(slot + C2_BK + (16 * kt + fr) * 80 + fq * 16); }
            s16x4 Vf[2];
#pragma unroll
            for (int i = 0; i < 2; ++i) Vf[i] = *(const LAS s16x4*)(slot + C2_VT + (32 * w + 16 * i + fr) * 32 + 4 * fq * 2);
            asm volatile("s_waitcnt lgkmcnt(0)" ::: "memory");
            if (lane == 0) *(volatile LAS unsigned*)(flags + 8 + w) = (unsigned)(ch + 1);
            f32x4 yv[2];
#pragma unroll
            for (int i = 0; i < 2; ++i) {
                bf16x8 Sb[2];
#pragma unroll
                for (int kp = 0; kp < 2; ++kp) { u32x4 pk; pk.x = cvt_pk_bf16(acc[i][2 * kp][0], acc[i][2 * kp][1]); pk.y = cvt_pk_bf16(acc[i][2 * kp][2], acc[i][2 * kp][3]);
                    pk.z = cvt_pk_bf16(acc[i][2 * kp + 1][0], acc[i][2 * kp + 1][1]); pk.w = cvt_pk_bf16(acc[i][2 * kp + 1][2], acc[i][2 * kp + 1][3]); Sb[kp] = __builtin_bit_cast(bf16x8, pk); }
                f32x4 rhs = {0.f, 0.f, 0.f, 0.f}; yv[i] = (f32x4){0.f, 0.f, 0.f, 0.f};
#pragma unroll
                for (int kp = 0; kp < 2; ++kp) { rhs = MFMA16(fa[kp], Sb[kp], rhs); yv[i] = MFMA16(fr2[kp], Sb[kp], yv[i]); }
                rhs = MFMA16(fmk, __builtin_shufflevector(z4, Vf[i], 0, 1, 2, 3, 4, 5, 6, 7), rhs);
                u32x2 rp; rp.x = cvt_pk_bf16(rhs[0], rhs[1]); rp.y = cvt_pk_bf16(rhs[2], rhs[3]);
                f32x4 uv = {0.f, 0.f, 0.f, 0.f};
                uv = MFMA16(ftt, __builtin_shufflevector(__builtin_bit_cast(s16x4, rp), z4, 0, 1, 2, 3, 4, 5, 6, 7), uv);
                u32x2 up; up.x = cvt_pk_bf16(uv[0], uv[1]); up.y = cvt_pk_bf16(uv[2], uv[3]);
                const bf16x8 UVb = __builtin_shufflevector(__builtin_bit_cast(s16x4, up), Vf[i], 0, 1, 2, 3, 4, 5, 6, 7);
                yv[i] = MFMA16(fnm, UVb, yv[i]);
#pragma unroll
                for (int kt = 0; kt < 4; ++kt) acc[i][kt] = MFMA16(bk[kt], UVb, acc[i][kt] * g4[kt]);
            }
#pragma unroll
            for (int i = 0; i < 2; ++i) {
                bf16_t* yp = Yg + (tok0 + (size_t)ch * 16 + 4 * fq) * DM + h * 64 + 32 * w + 16 * i + fr;
#pragma unroll
                for (int jj = 0; jj < 4; ++jj) yp[(size_t)jj * DM] = f2bf(yv[i][jj]);
            }
        }
    }
    __syncthreads();
}

DI void post_phase(const int wv_, const bf16_t* Y, const bf16_t* Vg, bf16_t* G, const float* bon, const float* lng, const float* lnb) {
    const int nthr = my_nblk() * 512;
    for (int i = my_bid() * 512 + my_tid(); i < T_TOK * 128; i += nthr) {
        const int tok = i >> 7, cg8 = i & 127, hh = cg8 >> 3;
        const size_t off = (size_t)tok * DM + cg8 * 8;
        const u32x4 yv = *(const u32x4*)(Y + off), vv = *(const u32x4*)(Vg + off), gv = *(const u32x4*)(G + off);
        const float bo = bon[(size_t)tok * 16 + hh];
        float y[8] = {bf_lo(yv.x), bf_hi(yv.x), bf_lo(yv.y), bf_hi(yv.y), bf_lo(yv.z), bf_hi(yv.z), bf_lo(yv.w), bf_hi(yv.w)};
        const float v[8] = {bf_lo(vv.x), bf_hi(vv.x), bf_lo(vv.y), bf_hi(vv.y), bf_lo(vv.z), bf_hi(vv.z), bf_lo(vv.w), bf_hi(vv.w)};
        const float gg[8] = {bf_lo(gv.x), bf_hi(gv.x), bf_lo(gv.y), bf_hi(gv.y), bf_lo(gv.z), bf_hi(gv.z), bf_lo(gv.w), bf_hi(gv.w)};
        float s = 0.f;
#pragma unroll
        for (int e = 0; e < 8; ++e) s += y[e];
        s += __shfl_xor(s, 1); s += __shfl_xor(s, 2); s += __shfl_xor(s, 4);
        const float mu = s * (1.0f / 64.0f);
        float q = 0.f;
#pragma unroll
        for (int e = 0; e < 8; ++e) { const float d = y[e] - mu; q += d * d; }
        q += __shfl_xor(q, 1); q += __shfl_xor(q, 2); q += __shfl_xor(q, 4);
        const float rs = rsqrtf(q * (1.0f / 64.0f) + 64e-5f);
        const f32x4 g0 = *(const f32x4*)(lng + cg8 * 8), g1 = *(const f32x4*)(lng + cg8 * 8 + 4), c0 = *(const f32x4*)(lnb + cg8 * 8), c1 = *(const f32x4*)(lnb + cg8 * 8 + 4);
        const float lg[8] = {g0[0], g0[1], g0[2], g0[3], g1[0], g1[1], g1[2], g1[3]}, lb[8] = {c0[0], c0[1], c0[2], c0[3], c1[0], c1[1], c1[2], c1[3]};
        float o[8];
#pragma unroll
        for (int e = 0; e < 8; ++e) o[e] = ((y[e] - mu) * rs * lg[e] + lb[e] + bo * v[e]) * gg[e];
        u32x4 r; r.x = cvt_pk_bf16(o[0], o[1]); r.y = cvt_pk_bf16(o[2], o[3]); r.z = cvt_pk_bf16(o[4], o[5]); r.w = cvt_pk_bf16(o[6], o[7]);
        *(u32x4*)(G + off) = r;
    }
}


#define XB_TMO      128
#define XB_XCNT(j)  (256  + 64 * (j))
#define XB_XSUB(j)  (1280 + 64 * (j))
#define XB_XGEN(j)  (2304 + 64 * (j))
#define XB_TOP      3328
#define XB_TOPGEN   3392
#define XCD_BAR_WORDS 3456
#define XB_SPIN_CAP (1u << 18)
DI unsigned xb_ld(unsigned* p)              { return __hip_atomic_load(p, __ATOMIC_RELAXED, __HIP_MEMORY_SCOPE_AGENT); }
DI unsigned xb_add(unsigned* p, unsigned v) { return __hip_atomic_fetch_add(p, v, __ATOMIC_RELAXED, __HIP_MEMORY_SCOPE_AGENT); }
DI unsigned xb_xcc_id() { return (unsigned)__builtin_amdgcn_s_getreg((3 << 11) | 20) & 0xFu; }
#define XB_SPIN(cond, bar) do { unsigned _sp = 0; while (cond) { __builtin_amdgcn_s_sleep(1); \
    if ((++_sp & 255u) == 0u) { if (xb_ld(&(bar)[XB_TMO])) break; if (_sp > XB_SPIN_CAP) { atomicAdd(&(bar)[XB_TMO], 1u); break; } } } } while (0)
DI void xcd_barrier_complete(unsigned* bar, unsigned x, unsigned G, unsigned& nloc, unsigned& nx) {
    unsigned sum, cnt, mine, sp = 0u;
    for (;;) {
        sum = 0u; cnt = 0u; mine = 0u;
#pragma unroll
        for (unsigned j = 0; j < 16; ++j) { const unsigned c = xb_ld(&bar[XB_XCNT(j)]); sum += c; cnt += (c > 0u) ? 1u : 0u; mine = (j == x) ? c : mine; }
        if (sum == G) break;
        __builtin_amdgcn_s_sleep(1);
        if ((++sp & 255u) == 0u) { if (xb_ld(&bar[XB_TMO])) break; if (sp > XB_SPIN_CAP) { atomicAdd(&bar[XB_TMO], 1u); break; } }
    }
    nloc = mine > 0u ? mine : 1u; nx = cnt > 0u ? cnt : 1u;
}
DI void xcd_barrier_(const int wv_, unsigned* bar, volatile LAS unsigned* st) {
    asm volatile("s_waitcnt vmcnt(0)" ::: "memory");
    __syncthreads();
    if (my_tid() == 0) {
        const unsigned x = xb_xcc_id();
        __builtin_amdgcn_s_waitcnt(0);
        unsigned nloc = st[0], nx = st[1];
        if (nloc == 0u) { xcd_barrier_complete(bar, x, (unsigned)my_nblk(), nloc, nx); st[0] = nloc; st[1] = nx; }
        const unsigned old = xb_add(&bar[XB_XSUB(x)], 1u);
        const unsigned gen = old / nloc;
        if (old + 1u == (gen + 1u) * nloc) {
            __builtin_amdgcn_fence(__ATOMIC_RELEASE, "agent");
            asm volatile("s_waitcnt vmcnt(0)" ::: "memory");
            const unsigned og = xb_add(&bar[XB_TOP], 1u);
            const unsigned tg = og / nx;
            if (og + 1u == (tg + 1u) * nx) xb_add(&bar[XB_TOPGEN], 1u);
            else XB_SPIN(xb_ld(&bar[XB_TOPGEN]) == tg, bar);
            __builtin_amdgcn_fence(__ATOMIC_ACQUIRE, "agent");
            xb_add(&bar[XB_XGEN(x)], 1u);
            asm volatile("s_waitcnt vmcnt(0)" ::: "memory");
        } else {
            XB_SPIN(xb_ld(&bar[XB_XGEN(x)]) == gen, bar);
            __builtin_amdgcn_fence(__ATOMIC_ACQUIRE, "agent");
            asm volatile("s_waitcnt vmcnt(0)" ::: "memory");
        }
    }
    __syncthreads();
}

constexpr int NJOBS = 28, JOB_PERSIST = 16;
struct Params {
    const float* in[29];
    float* out; unsigned char* ws;
    ConvJob jobs[NJOBS];
    int ph_lo, ph_hi; unsigned dup_mask; int pad2_;
};
constexpr int NPHASE = 24;

#ifdef DBG_NAN
DI bool bad_bf(unsigned short v) { return (v & 0x7f80) == 0x7f80; }
DI bool bad_f(float v) { return !(fabsf(v) <= 3.0e38f); }
DI void dbg_scan(const int wv_, const Params& p, unsigned* flags) {
    unsigned char* ws = p.ws;
    const bf16_t* Y0 = (const bf16_t*)(ws + WS_B7); const bf16_t* Y1 = (const bf16_t*)(ws + WS_B5);
    const float* b0 = (const float*)(ws + WS_BON); const float* b1 = (const float*)(ws + WS_LSE);
    const size_t gt = (size_t)my_bid() * 512 + my_tid(), nth = (size_t)my_nblk() * 512;
    float m0 = 0.f, md = 0.f, mb = 0.f, mbd = 0.f;
    for (size_t i = gt; i < (size_t)T_TOK * DM; i += nth) { const float a = bf2f(Y0[i]), c = bf2f(Y1[i]); const float d = fabsf(a - c); m0 = fmaxf(m0, fabsf(a)); md = (d == d) ? fmaxf(md, d) : 1e30f; }
    for (size_t i = gt; i < (size_t)T_TOK * 16; i += nth) { const float a = b0[i], c = b1[i]; const float d = fabsf(a - c); mb = fmaxf(mb, fabsf(a)); mbd = (d == d) ? fmaxf(mbd, d) : 1e30f; }
    atomicMax(flags + 0, __float_as_uint(m0)); atomicMax(flags + 1, __float_as_uint(md)); atomicMax(flags + 2, __float_as_uint(mb)); atomicMax(flags + 3, __float_as_uint(mbd));
}
#endif
DI void do_phase(const int wv_, const int ph, const Params& p, LAS unsigned char* lds) {
    unsigned char* ws = p.ws;
    bf16_t* HN = (bf16_t*)(ws + WS_HN); bf16_t* HID = (bf16_t*)(ws + WS_HID); bf16_t* GU = (bf16_t*)(ws + WS_GU); bf16_t* DN = (bf16_t*)(ws + WS_DN);
    bf16_t* PROJ = (bf16_t*)(ws + WS_PROJ); bf16_t* OG = (bf16_t*)(ws + WS_OG); bf16_t* MERGED = (bf16_t*)(ws + WS_MERGED); float* LSE = (float*)(ws + WS_LSE);
    bf16_t* B1 = (bf16_t*)(ws + WS_B1); bf16_t* B2 = (bf16_t*)(ws + WS_B2); bf16_t* B3 = (bf16_t*)(ws + WS_B3); bf16_t* B4 = (bf16_t*)(ws + WS_B4);
    bf16_t* B5 = (bf16_t*)(ws + WS_B5); bf16_t* B6 = (bf16_t*)(ws + WS_B6); bf16_t* B7 = (bf16_t*)(ws + WS_B7); float* BON = (float*)(ws + WS_BON);
    const float* x_in = p.in[0]; float* out = p.out; bf16_t* XS0 = (bf16_t*)p.out; bf16_t* XS1 = (bf16_t*)(ws + WS_XS1); bf16_t* YR = (bf16_t*)((unsigned char*)p.out + 64 * MiB); bf16_t* GU2 = (bf16_t*)(ws + WS_GU2); bf16_t* DN2 = (bf16_t*)(ws + WS_DN2);
    {
        switch (ph) {
        case 0: conv_phase(wv_, p.jobs, 0, JOB_PERSIST + 3, lds); norm_phase<false>(wv_, x_in, p.in[1] + 0 * DM, HN, 0); break;
        case 1: case 9: case 12: { EpiSwiGLU E; E.H = HID; run_gemm(wv_, lds, HN, GU, 2 * DFF, DM, DM, DM, 0, E); } break;
        case 22: { EpiSwiGLU E; E.H = HID; run_gemm(wv_, lds, HN, GU2, 2 * DFF, DM, DM, DM, 0, E); } break;
        case 2: { EpiResid<false, true> E; E.X = x_in; E.O = XS0; E.scale = 0.5f; run_gemm(wv_, lds, HID, DN, DM, DFF, DFF, DFF, 0, E); } break;
        case 10: case 13: { EpiResid<true, true> E; E.X = XS0; E.O = XS0; E.scale = 0.5f; run_gemm(wv_, lds, HID, DN, DM, DFF, DFF, DFF, 0, E); } break;
        case 23: { EpiResid<true, false> E; E.X = XS1; E.O = out; E.scale = 0.5f; run_gemm(wv_, lds, HID, DN2, DM, DFF, DFF, DFF, 0, E); } break;
        case 3: conv_phase(wv_, p.jobs, JOB_PERSIST + 3, JOB_PERSIST + 6, lds); norm_phase<true>(wv_, XS0, p.in[5] + 0 * DM, HN, 0); break;
        case 4: { EpiBf16<0> E; E.O = PROJ; E.ldc = 3072; E.bias = nullptr; run_gemm(wv_, lds, HN, (const bf16_t*)(ws + WS_WIN), 3072, DM, DM, DM, 0, E); } break;
        case 5: attn_phase(wv_, PROJ, MERGED, OG, LSE, p.in[6], p.in[8], p.in[9], lds); break;
        case 6: combine_phase(wv_, OG, LSE, MERGED); break;
        case 7: { EpiResid<true, true> E; E.X = XS0; E.O = XS0; E.scale = 1.0f; run_gemm(wv_, lds, MERGED, (const bf16_t*)(ws + WS_WOUT), DM, 512, 512, 512, 0, E); } break;
        case 8: norm_phase<true>(wv_, XS0, p.in[1] + 1 * DM, HN, 0); break;
        case 11: conv_phase(wv_, p.jobs, JOB_PERSIST + 6, JOB_PERSIST + 9, lds); norm_phase<true>(wv_, XS0, p.in[1] + 2 * DM, HN, 0); break;
        case 14: normmix_phase(wv_, XS0, p.in[5] + 1 * DM, p.in[11], B1, B2, B3, B4); break;
        case 15: {
            EpiBf16<0> E; E.ldc = DM; E.bias = nullptr;
            E.O = B5; run_gemm(wv_, lds, B2, (const bf16_t*)(ws + WS_WR), DM, DM, DM, DM, 0, E);
            E.O = B6; run_gemm(wv_, lds, B3, (const bf16_t*)(ws + WS_WK), DM, DM, DM, DM, 0, E);
            EpiBf16<1> E1; E1.O = B7; E1.ldc = 512; E1.bias = nullptr; run_gemm(wv_, lds, B1, (const bf16_t*)(ws + WS_L1), 512, 2048, DM, 2048, 2048, E1);
        } break;
        case 16: {
            EpiBf16<0> E; E.ldc = DM; E.bias = nullptr;
            E.O = B2; run_gemm(wv_, lds, B4, (const bf16_t*)(ws + WS_WV), DM, DM, DM, DM, 0, E);
            EpiBf16<2> Ew; Ew.O = B3; Ew.ldc = DM; Ew.bias = p.in[12]; run_gemm(wv_, lds, B7, (const bf16_t*)(ws + WS_L2W), DM, 128, 512, 128, 0, Ew);
            EpiBf16<3> Ea; Ea.O = YR; Ea.ldc = DM; Ea.bias = p.in[15]; run_gemm(wv_, lds, B7, (const bf16_t*)(ws + WS_L2A), DM, 128, 512, 128, 0, Ea);
        } break;
        case 18:
#ifdef SCAN_DEBUG
            for (int it = my_bid(); it < 256; it += my_nblk()) scan_item(wv_, B5, B6, B2, B3, B4, B7, BON, p.in[20], p.in[21], p.in[22], lds, it >> 5, (it >> 1) & 15, it & 1);
#else
            {
                const int half = my_nblk() >> 1;
                if (my_bid() < half) { for (int it = my_bid(); it < 128; it += half) scan2_item(wv_, B5, B6, B2, B3, YR, YR, BON, p.in[20], p.in[21], p.in[22], lds, it >> 4, it & 15); }
                else {
                    EpiBf16<0> Eg; Eg.O = B1; Eg.ldc = DM; Eg.bias = nullptr; run_gemm(wv_, lds, B7 + 128, (const bf16_t*)(ws + WS_L2G), DM, 256, 512, 256, 0, Eg, my_nblk() - half, my_bid() - half);
                    conv_phase(wv_, p.jobs, JOB_PERSIST + 9, JOB_PERSIST + 12, lds, my_nblk() - half, my_bid() - half);
                }
            }
#endif
            break;
        case 19:
#ifdef SCAN_DEBUG
            for (int it = my_bid(); it < 128; it += my_nblk()) scan2_item(wv_, B5, B6, B2, B3, B4, B5, (float*)(ws + WS_LSE), p.in[20], p.in[21], p.in[22], lds, it >> 4, it & 15);
#endif
            post_phase(wv_, YR, B2, B1, BON, p.in[27], p.in[28]); break;
        case 20: { EpiResid<true, true> E; E.X = XS0; E.O = XS1; E.scale = 1.0f; run_gemm(wv_, lds, B1, (const bf16_t*)(ws + WS_WO), DM, DM, DM, DM, 0, E); } break;
        case 21: norm_phase<true>(wv_, XS1, p.in[1] + 3 * DM, HN, 0); break;
#ifdef DBG_NAN
        case NPHASE: dbg_scan(wv_, p, (unsigned*)(p.ws + WS_FLAGS)); break;
        case NPHASE + 1: if (my_bid() == 0 && my_tid() == 0) { const unsigned c = *(volatile unsigned*)(p.ws + WS_FLAGS); const volatile unsigned* f = (const volatile unsigned*)(p.ws + WS_FLAGS); const float m0 = __uint_as_float(f[0]), md = __uint_as_float(f[1]), mb = __uint_as_float(f[2]), mbd = __uint_as_float(f[3]);
            (void)c; p.out[0] = DBG_SEL == 0 ? 1.0e6f * fminf(md / m0, 1.0e3f) : (DBG_SEL == 1 ? 1.0e6f * fminf(mbd / mb, 1.0e3f) : 1.0e6f * m0); } break;
#endif
        default: break;
        }
    }
}


__global__ void __launch_bounds__(512, 2) fwd_mega(const Params p) {
    extern __shared__ __attribute__((aligned(16))) unsigned char shm[];
    LAS unsigned char* lds = (LAS unsigned char*)shm;
    cg::grid_group grid = cg::this_grid();
#ifdef DBG_NAN
    const int nseq = p.ph_hi + 2;
#else
    const int nseq = p.ph_hi;
#endif
    const int wv0 = __builtin_amdgcn_readfirstlane((int)(threadIdx.x >> 6));
    volatile LAS unsigned* xst = (volatile LAS unsigned*)(lds + LDS_BYTES - 16);
    unsigned* xbar = (unsigned*)(p.ws + WS_BAR);
    {
        int wv_ = wv0; asm volatile("" : "+s"(wv_));
        if (my_tid() == 0) { xst[0] = 0u; xst[1] = 0u; (void)xb_add(&xbar[XB_XCNT(xb_xcc_id())], 1u); }
        __syncthreads();
    }
    for (int i = p.ph_lo; i < nseq; ++i) {
        const int ph = i < p.ph_hi ? i : NPHASE + (i - p.ph_hi);
        if (ph == 17) continue;
        const int reps = 1 + (int)((p.dup_mask >> ph) & 1u);
        for (int r = 0; r < reps; ++r) {
            int wv_ = wv0; asm volatile("" : "+s"(wv_));
            do_phase(wv_, ph, p, lds);
            if (i + 1 < nseq || r + 1 < reps) { if (p.ph_hi < 0) grid.sync(); else xcd_barrier_(wv_, xbar, xst); }
        }
    }
}

static void set_job(ConvJob& J, const float* src, const float* scale, bf16_t* dst, int Ks, int Ns, int ldd, int rb, int NR, int r0, int cb, int NC, int c0, int flags) {
    J.src = src; J.scale = scale; J.dst = dst; J.Ks = Ks; J.Ns = Ns; J.ldd = ldd; J.rb = rb; J.NR = NR; J.r0 = r0; J.cb = cb; J.NC = NC; J.c0 = c0; J.flags = flags; J.pad_ = 0;
}

extern "C" void kernel_launch(void* const* d_in, const int* in_sizes, int n_in, void* d_out, int out_size, void* d_ws, size_t ws_size, hipStream_t stream) {
    static int grid = 0;
    if (grid == 0) {
        if (n_in != 29 || out_size != T_TOK * DM || ws_size < WS_NEED) { fprintf(stderr, "kernel_launch: unexpected shapes / workspace (n_in %d out %d ws %zu need %zu)\n", n_in, out_size, ws_size, (size_t)WS_NEED); grid = -1; return; }
        if (hipFuncSetAttribute((const void*)fwd_mega, hipFuncAttributeMaxDynamicSharedMemorySize, LDS_BYTES) != hipSuccess) { fprintf(stderr, "kernel_launch: hipFuncSetAttribute failed\n"); grid = -1; return; }
        int dev = 0, cus = 0, per_cu = 0;
        hipGetDevice(&dev); hipDeviceGetAttribute(&cus, hipDeviceAttributeMultiprocessorCount, dev);
        hipOccupancyMaxActiveBlocksPerMultiprocessor(&per_cu, (const void*)fwd_mega, 512, LDS_BYTES);
        if (per_cu < 1) { fprintf(stderr, "kernel_launch: occupancy query says %d blocks per CU\n", per_cu); per_cu = 1; }
        (void)hipGetLastError();
        grid = cus * 1;
    }
    if (grid < 0) return;
    Params p{};
    for (int i = 0; i < 29; ++i) p.in[i] = (const float*)d_in[i];
    p.out = (float*)d_out; p.ws = (unsigned char*)d_ws;
    unsigned char* ws = (unsigned char*)d_ws;
    int nj = 0;
    const float* mix = p.in[11];
    set_job(p.jobs[nj++], p.in[7], nullptr, (bf16_t*)(ws + WS_WIN), 1024, 3072, 1024, 0, 3072, 0, 0, 1024, 0, 0);
    set_job(p.jobs[nj++], p.in[10], nullptr, (bf16_t*)(ws + WS_WOUT), 512, 1024, 512, 0, 1024, 0, 0, 512, 0, 0);
    set_job(p.jobs[nj++], p.in[23], nullptr, (bf16_t*)(ws + WS_WR), 1024, 1024, 1024, 0, 1024, 0, 0, 1024, 0, 0);
    set_job(p.jobs[nj++], p.in[24], nullptr, (bf16_t*)(ws + WS_WK), 1024, 1024, 1024, 0, 1024, 0, 0, 1024, 0, 0);
    set_job(p.jobs[nj++], p.in[25], nullptr, (bf16_t*)(ws + WS_WV), 1024, 1024, 1024, 0, 1024, 0, 0, 1024, 0, 0);
    set_job(p.jobs[nj++], p.in[26], nullptr, (bf16_t*)(ws + WS_WO), 1024, 1024, 1024, 0, 1024, 0, 0, 1024, 0, 0);
    set_job(p.jobs[nj++], p.in[13], mix + 1 * 1024, (bf16_t*)(ws + WS_L1), 1024, 64, 2048, 0, 64, 0, 0, 1024, 0, 1 << 1);
    set_job(p.jobs[nj++], p.in[13], mix + 1 * 1024, (bf16_t*)(ws + WS_L1), 1024, 64, 2048, 0, 64, 0, 1024, 1024, 1024, 2 << 1);
    set_job(p.jobs[nj++], p.in[16], mix + 4 * 1024, (bf16_t*)(ws + WS_L1), 1024, 64, 2048, 64, 64, 64, 0, 1024, 0, 1 << 1);
    set_job(p.jobs[nj++], p.in[16], mix + 4 * 1024, (bf16_t*)(ws + WS_L1), 1024, 64, 2048, 64, 64, 64, 1024, 1024, 1024, 2 << 1);
    set_job(p.jobs[nj++], p.in[18], mix + 5 * 1024, (bf16_t*)(ws + WS_L1), 1024, 160, 2048, 128, 192, 128, 0, 1024, 0, 1 << 1);
    set_job(p.jobs[nj++], p.in[18], mix + 5 * 1024, (bf16_t*)(ws + WS_L1), 1024, 160, 2048, 128, 192, 128, 1024, 1024, 1024, 2 << 1);
    set_job(p.jobs[nj++], nullptr, nullptr, (bf16_t*)(ws + WS_L1), 0, 0, 2048, 320, 192, 320, 0, 2048, 0, 0);
    set_job(p.jobs[nj++], p.in[14], nullptr, (bf16_t*)(ws + WS_L2W), 64, 1024, 128, 0, 1024, 0, 0, 128, 0, 0);
    set_job(p.jobs[nj++], p.in[17], nullptr, (bf16_t*)(ws + WS_L2A), 64, 1024, 128, 0, 1024, 0, 0, 128, 64, 0);
    set_job(p.jobs[nj++], p.in[19], nullptr, (bf16_t*)(ws + WS_L2G), 160, 1024, 256, 0, 1024, 0, 0, 256, 0, 0);
    for (int f = 0; f < 4; ++f) {
        const float* wg = p.in[2] + (size_t)f * DM * DFF; const float* wu = p.in[3] + (size_t)f * DM * DFF; const float* wd = p.in[4] + (size_t)f * DFF * DM;
        bf16_t* gu = (bf16_t*)(ws + (f == 3 ? WS_GU2 : WS_GU)); bf16_t* dn = (bf16_t*)(ws + (f == 3 ? WS_DN2 : WS_DN));
        set_job(p.jobs[nj++], wg, nullptr, gu, 1024, DFF, 1024, 0, DFF, 0, 0, 1024, 0, 1);
        set_job(p.jobs[nj++], wu, nullptr, gu, 1024, DFF, 1024, 128, DFF, 128, 0, 1024, 0, 1);
        set_job(p.jobs[nj++], wd, nullptr, dn, DFF, 1024, DFF, 0, 1024, 0, 0, DFF, 0, 0);
    }
    p.ph_lo = 0; p.ph_hi = NPHASE; p.dup_mask = DUPMASK;
#ifdef DBG_NAN
    hipMemsetAsync(ws + WS_FLAGS, 0, 256, stream);
#endif
    if (hipMemsetAsync(ws + WS_BAR, 0, XCD_BAR_WORDS * 4, stream) != hipSuccess) { fprintf(stderr, "kernel_launch: memset of the barrier words failed\n"); return; }
    void* args[] = {(void*)&p};
    hipError_t e = hipLaunchCooperativeKernel((const void*)fwd_mega, dim3(grid), dim3(512), args, LDS_BYTES, stream);
    if (e != hipSuccess) fprintf(stderr, "kernel_launch: cooperative launch failed: %s (grid %d)\n", hipGetErrorString(e), grid);
}
```

```cpp
#include <hip/hip_runtime.h>
#include <hip/hip_cooperative_groups.h>
#include <cstdio>
#ifdef SCAN_DEBUG
#define DBG_NAN 1
#define DBG_SEL 0
#endif
#ifndef DUPMASK
#define DUPMASK 0u
#endif

namespace cg = cooperative_groups;

#define DI __device__ __forceinline__
#define LAS __attribute__((address_space(3)))
typedef unsigned short bf16_t;
typedef short bf16x8 __attribute__((ext_vector_type(8)));
typedef short s16x4 __attribute__((ext_vector_type(4)));
typedef float f32x4 __attribute__((ext_vector_type(4)));
typedef float f32x2 __attribute__((ext_vector_type(2)));
typedef unsigned u32x4 __attribute__((ext_vector_type(4)));
typedef unsigned u32x2 __attribute__((ext_vector_type(2)));
typedef _Float16 h16x2 __attribute__((ext_vector_type(2)));

constexpr int T_TOK = 32768, DM = 1024, SEQ = 4096, DFF = 2816;
constexpr size_t MiB = 1ull << 20;
constexpr size_t WS_WIN = 0, WS_WOUT = 6 * MiB, WS_WR = 7 * MiB, WS_WK = 11 * MiB, WS_WV = 15 * MiB, WS_WO = 19 * MiB, WS_L1 = 21 * MiB,
                 WS_L2W = 23 * MiB, WS_L2A = 23 * MiB + 512 * 1024, WS_L2G = 24 * MiB, WS_BON = 25 * MiB, WS_LSE = 27 * MiB, WS_FLAGS = 30 * MiB, WS_BAR = 31 * MiB, WS_XS1 = 296 * MiB, WS_GU2 = 481 * MiB, WS_DN2 = 492 * MiB;
constexpr size_t WS_HN = 32 * MiB, WS_HID = 96 * MiB, WS_PROJ = 96 * MiB, WS_OG = 288 * MiB, WS_MERGED = 336 * MiB, WS_GU = 384 * MiB, WS_DN = 395 * MiB;
constexpr size_t RBUF = 64 * MiB + 65536;
constexpr size_t WS_B1 = 32 * MiB, WS_B2 = WS_B1 + RBUF, WS_B3 = WS_B2 + RBUF, WS_B4 = WS_B3 + RBUF, WS_B5 = WS_B4 + RBUF, WS_B6 = WS_B5 + RBUF, WS_B7 = WS_B6 + RBUF;
constexpr size_t WS_NEED = 498 * MiB;
constexpr int LDS_BYTES = 147456;

DI int my_tid_(int wv) { unsigned m = ~0u; asm volatile("" : "+s"(m)); const int l = (int)__builtin_amdgcn_mbcnt_hi(m, __builtin_amdgcn_mbcnt_lo(m, 0u)); return wv * 64 + l; }
#define my_tid() my_tid_(wv_)
DI int my_bid() { int t = blockIdx.x; asm volatile("" : "+s"(t)); return t; }
DI int my_nblk() { int t = gridDim.x; asm volatile("" : "+s"(t)); return t; }
typedef __bf16 bf16x2_t __attribute__((ext_vector_type(2)));
DI unsigned cvt_pk_bf16(float lo, float hi) { const f32x2 v = {lo, hi}; const bf16x2_t b = __builtin_convertvector(v, bf16x2_t); return __builtin_bit_cast(unsigned, b); }
DI float bf_lo(unsigned u) { return __uint_as_float(u << 16); }
DI float bf_hi(unsigned u) { return __uint_as_float(u & 0xffff0000u); }
DI float fast_exp(float x) { return __builtin_amdgcn_exp2f(x * 1.44269504089f); }
DI float fast_log(float x) { return __builtin_amdgcn_logf(x) * 0.69314718056f; }
DI float fast_rcp(float x) { return __builtin_amdgcn_rcpf(x); }
DI float sigmoidf_(float x) { return fast_rcp(1.0f + fast_exp(-x)); }

namespace pg8 {
constexpr int BM = 256, BK = 64, HALF = 128, HTB = HALF * BK * 2, STAGE_BYTES = 8 * HTB, NXCD = 8, WGM = 4;
DI int lds_byte(int r, int c) { const int st = (r >> 4) * 2 + (c >> 5), rr = r & 15, cc = c & 31, ob = rr * 64 + cc * 2; return st * 1024 + (ob ^ (((ob >> 9) & 1) << 5)); }
DI void stage_rc(int b_, int& R, int& C) { const unsigned b = (unsigned)b_; const unsigned st = b >> 10, sb = b & 1023u, swz = sb ^ (((sb >> 9) & 1u) << 5); R = (int)((st >> 1) * 16u + (swz >> 6)); C = (int)((st & 1u) * 32u + ((swz & 63u) >> 1)); }
DI int perm32(int rho) { const int n = rho >> 4, i = rho & 15; return 8 * (i >> 2) + 4 * n + (i & 3); }
struct Unit { int pm, pn; };
struct Gemm { const bf16_t* A; const bf16_t* Bt; int M, N, K, lda, ldb, gapA; };
struct StaticOrder {
    int nM, nN, nwg, G, c;
    DI void init(int M, int N, int G_, int c_) { nM = M / BM; nN = N / BM; nwg = nM * nN; G = G_; c = c_; }
    DI bool next(int i, Unit& u) const {
        const long L = (long)i * G + c; if (L >= nwg) return false;
        int wgid = (int)L; { const int q = nwg / NXCD, r = nwg % NXCD, xcd = wgid % NXCD, off = wgid / NXCD; wgid = (xcd < r ? xcd * (q + 1) : r * (q + 1) + (xcd - r) * q) + off; }
        const int nig = WGM * nN, gid = wgid / nig, fm = gid * WGM, gsz = (nM - fm) < WGM ? (nM - fm) : WGM;
        u.pm = fm + ((wgid % nig) % gsz); u.pn = (wgid % nig) / gsz; return true;
    }
};

template <class Epi>
DI void gemm_phase(const int wv_, LAS unsigned char* lds, const Gemm g, const StaticOrder& S, const Epi& E) {
    const int tid = my_tid(), wid = __builtin_amdgcn_readfirstlane(tid >> 6), lane = tid & 63, wr = wid >> 2, wc = wid & 3, fr = lane & 15, fq = lane >> 4;
    const int K = g.K, nt = K / BK;
    unsigned voffA[2], voffB[2];
#pragma unroll
    for (int i = 0; i < 2; ++i) { int R, C; stage_rc(tid * 16 + i * 8192, R, C); const int Rb = Epi::PERM ? ((R & ~31) + perm32(R & 31)) : R;
        voffA[i] = (unsigned)(R * g.lda + C) * 2u; voffB[i] = (unsigned)(Rb * g.ldb + C) * 2u; }
    const size_t kstep = (size_t)(BK * 2);
    const size_t hstepA = (size_t)HALF * g.lda * 2, hstepB = (size_t)HALF * g.ldb * 2;
    const size_t tstepA = 2 * hstepA, tstepB = 2 * hstepB;
    const unsigned ldsw = (unsigned)wid * 1024u;
    const int aoff = lds_byte(wr * 64 + fr, fq * 8), boff = lds_byte(wc * 32 + fr, fq * 8);
#define PG8_SA(b, h) (((b) * 2 + (h)) * HTB)
#define PG8_SB(b, h) ((4 + (b) * 2 + (h)) * HTB)
#define PG8_STAGE(bufoff, gbase, voff) do { _Pragma("unroll") for (int _i = 0; _i < 2; ++_i) { unsigned _vo = (voff)[_i]; asm volatile("" : "+v"(_vo)); \
        __builtin_amdgcn_global_load_lds((const unsigned*)((const char*)(gbase) + _vo), (LAS unsigned*)(lds + (bufoff) + ldsw + _i * 8192), 16, 0, 0); } } while (0)
#define PG8_LDA(dst, b, h) do { _Pragma("unroll") for (int m = 0; m < 4; ++m) _Pragma("unroll") for (int k = 0; k < 2; ++k) dst[m][k] = *(const LAS bf16x8*)(lds + PG8_SA(b, h) + aoff + m * 2048 + k * 1024); } while (0)
#define PG8_LDB(dst, b, h) do { _Pragma("unroll") for (int n = 0; n < 2; ++n) _Pragma("unroll") for (int k = 0; k < 2; ++k) dst[n][k] = *(const LAS bf16x8*)(lds + PG8_SB(b, h) + boff + n * 2048 + k * 1024); } while (0)
#define PG8_MMA(ai, bj, At, Bt) do { __builtin_amdgcn_s_setprio(1); _Pragma("unroll") for (int m = 0; m < 4; ++m) _Pragma("unroll") for (int n = 0; n < 2; ++n) _Pragma("unroll") for (int k = 0; k < 2; ++k) \
        acc[ai][bj][m][n] = __builtin_amdgcn_mfma_f32_16x16x32_bf16(Bt[n][k], At[m][k], acc[ai][bj][m][n], 0, 0, 0); __builtin_amdgcn_s_setprio(0); } while (0)
#define PG8_WAIT_V(n) asm volatile("s_waitcnt vmcnt(" #n ")" ::: "memory")
#define PG8_WAIT_L(n) asm volatile("s_waitcnt lgkmcnt(" #n ")" ::: "memory")
#define PG8_BAR __builtin_amdgcn_s_barrier()
#define PG8_SCHED __builtin_amdgcn_sched_barrier(0)
    Unit cur, nxt; int ui = 0;
    if (!S.next(0, cur)) return;
    f32x4 acc[2][2][4][2];
#pragma unroll
    for (int a = 0; a < 2; ++a)
#pragma unroll
        for (int b = 0; b < 2; ++b)
#pragma unroll
            for (int m = 0; m < 4; ++m)
#pragma unroll
                for (int n = 0; n < 2; ++n) acc[a][b][m][n] = (f32x4){0.f, 0.f, 0.f, 0.f};
    bf16x8 At[4][2], B0[2][2], B1[2][2];
    const char* cA = (const char*)g.A + (size_t)cur.pm * tstepA + (size_t)(cur.pm >> 4) * (size_t)g.gapA; const char* cB = (const char*)g.Bt + (size_t)cur.pn * tstepB;
    PG8_STAGE(PG8_SB(0, 0), cB, voffB); PG8_STAGE(PG8_SA(0, 0), cA, voffA); PG8_STAGE(PG8_SB(0, 1), cB + hstepB, voffB); PG8_STAGE(PG8_SA(0, 1), cA + hstepA, voffA);
    if (wr == 1) PG8_BAR;
    PG8_WAIT_V(4); PG8_BAR;
    PG8_STAGE(PG8_SB(1, 0), cB + kstep, voffB); PG8_STAGE(PG8_SA(1, 0), cA + kstep, voffA); PG8_STAGE(PG8_SB(1, 1), cB + hstepB + kstep, voffB);
    PG8_WAIT_V(6); PG8_BAR;
    for (;;) {
        const bool has_next = S.next(ui + 1, nxt);
        const char* nA = has_next ? (const char*)g.A + (size_t)nxt.pm * tstepA + (size_t)(nxt.pm >> 4) * (size_t)g.gapA : cA; const char* nB = has_next ? (const char*)g.Bt + (size_t)nxt.pn * tstepB : cB;
        for (int t = 0; t < nt; t += 2) {
            const bool last = (t == nt - 2);
            const char* a1 = cA + (size_t)(t + 1) * kstep;
            const char* a2 = last ? nA : cA + (size_t)(t + 2) * kstep; const char* b2 = last ? nB : cB + (size_t)(t + 2) * kstep;
            const char* a3 = a2 + kstep; const char* b3 = b2 + kstep;
            PG8_LDB(B0, 0, 0); PG8_SCHED; PG8_LDA(At, 0, 0); PG8_STAGE(PG8_SA(1, 1), a1 + hstepA, voffA);
            PG8_WAIT_L(8); PG8_BAR; PG8_WAIT_L(0); PG8_MMA(0, 0, At, B0); PG8_BAR; PG8_SCHED;
            PG8_LDB(B1, 0, 1); PG8_STAGE(PG8_SB(0, 0), b2, voffB);
            PG8_BAR; PG8_WAIT_L(0); PG8_MMA(0, 1, At, B1); PG8_BAR;
            PG8_LDA(At, 0, 1); PG8_STAGE(PG8_SA(0, 0), a2, voffA);
            PG8_BAR; PG8_WAIT_L(0); PG8_MMA(1, 0, At, B0); PG8_BAR; PG8_SCHED;
            PG8_STAGE(PG8_SB(0, 1), b2 + hstepB, voffB);
            PG8_WAIT_V(6); PG8_BAR; PG8_MMA(1, 1, At, B1); PG8_BAR;
            PG8_LDB(B0, 1, 0); PG8_SCHED; PG8_LDA(At, 1, 0); PG8_STAGE(PG8_SA(0, 1), a2 + hstepA, voffA);
            PG8_WAIT_L(8); PG8_BAR; PG8_WAIT_L(0); PG8_MMA(0, 0, At, B0); PG8_BAR; PG8_SCHED;
            PG8_LDB(B1, 1, 1); PG8_STAGE(PG8_SB(1, 0), b3, voffB);
            PG8_BAR; PG8_WAIT_L(0); PG8_MMA(0, 1, At, B1); PG8_BAR;
            PG8_LDA(At, 1, 1); PG8_STAGE(PG8_SA(1, 0), a3, voffA);
            PG8_BAR; PG8_WAIT_L(0); PG8_MMA(1, 0, At, B0); PG8_BAR; PG8_SCHED;
            PG8_STAGE(PG8_SB(1, 1), b3 + hstepB, voffB);
            PG8_WAIT_V(6); PG8_BAR; PG8_MMA(1, 1, At, B1); PG8_BAR;
        }
        { const int lane2 = my_tid() & 63; E(acc, cur, wr, wc, lane2 & 15, lane2 >> 4); }
        if (!has_next) break;
#pragma unroll
        for (int a = 0; a < 2; ++a)
#pragma unroll
            for (int b = 0; b < 2; ++b)
#pragma unroll
                for (int m = 0; m < 4; ++m)
#pragma unroll
                    for (int n = 0; n < 2; ++n) acc[a][b][m][n] = (f32x4){0.f, 0.f, 0.f, 0.f};
        cur = nxt; cA = nA; cB = nB; ++ui;
    }
    PG8_WAIT_V(0);
    if (wr == 0) PG8_BAR;
    PG8_BAR;
#undef PG8_SA
#undef PG8_SB
#undef PG8_STAGE
#undef PG8_LDA
#undef PG8_LDB
#undef PG8_MMA
#undef PG8_WAIT_V
#undef PG8_WAIT_L
#undef PG8_BAR
#undef PG8_SCHED
}
}
using pg8::Unit;

struct EpiSwiGLU {
    static constexpr bool PERM = true;
    bf16_t* H;
    DI void operator()(const f32x4 (&acc)[2][2][4][2], const Unit& u, int wr, int wc, int fr, int fq) const {
        const int row0 = u.pm * 256 + wr * 64 + fr, col0 = u.pn * 128 + wc * 32 + 8 * fq;
#pragma unroll
        for (int ai = 0; ai < 2; ++ai)
#pragma unroll
            for (int m = 0; m < 4; ++m) {
                bf16_t* rowp = H + (size_t)(row0 + ai * 128 + m * 16) * DFF + col0;
                float hv[8];
#pragma unroll
                for (int n = 0; n < 2; ++n)
#pragma unroll
                    for (int j = 0; j < 4; ++j) { const float gt = acc[ai][0][m][n][j], up = acc[ai][1][m][n][j]; hv[n * 4 + j] = gt * sigmoidf_(gt) * up; }
                u32x4 w; w.x = cvt_pk_bf16(hv[0], hv[1]); w.y = cvt_pk_bf16(hv[2], hv[3]); w.z = cvt_pk_bf16(hv[4], hv[5]); w.w = cvt_pk_bf16(hv[6], hv[7]);
                __builtin_nontemporal_store(w, (u32x4*)rowp);
            }
    }
};
template <bool BF> DI f32x4 ldx4(const void* X, size_t o) {
    if (BF) { const u32x2 w = *(const u32x2*)((const bf16_t*)X + o); return (f32x4){bf_lo(w.x), bf_hi(w.x), bf_lo(w.y), bf_hi(w.y)}; }
    else return *(const f32x4*)((const float*)X + o);
}
template <bool BF> DI void stx4(void* O, size_t o, const f32x4 r) {
    if (BF) { u32x2 w; w.x = cvt_pk_bf16(r[0], r[1]); w.y = cvt_pk_bf16(r[2], r[3]); *(u32x2*)((bf16_t*)O + o) = w; }
    else *(f32x4*)((float*)O + o) = r;
}
template <bool XBF, bool OBF> struct EpiResid {
    static constexpr bool PERM = false;
    const void* X; void* O; float scale;
    DI void operator()(const f32x4 (&acc)[2][2][4][2], const Unit& u, int wr, int wc, int fr, int fq) const {
        const int row0 = u.pm * 256 + wr * 64 + fr, col0 = u.pn * 256 + wc * 32 + 4 * fq;
#pragma unroll
        for (int ai = 0; ai < 2; ++ai)
#pragma unroll
            for (int m = 0; m < 4; ++m) {
                const size_t ro = (size_t)(row0 + ai * 128 + m * 16) * DM + col0;
#pragma unroll
                for (int bj = 0; bj < 2; ++bj)
#pragma unroll
                    for (int n = 0; n < 2; ++n) { const size_t o = ro + bj * 128 + n * 16; const f32x4 x = ldx4<XBF>(X, o); stx4<OBF>(O, o, x + acc[ai][bj][m][n] * scale); }
            }
    }
};
template <int MODE> struct EpiBf16 {
    static constexpr bool PERM = true;
    bf16_t* O; int ldc; const float* bias;
    DI void operator()(const f32x4 (&acc)[2][2][4][2], const Unit& u, int wr, int wc, int fr, int fq) const {
        const int row0 = u.pm * 256 + wr * 64 + fr, col0 = u.pn * 256 + wc * 32 + 8 * fq;
#pragma unroll
        for (int bj = 0; bj < 2; ++bj) {
            const int col = col0 + bj * 128;
            f32x4 b0 = (f32x4){0.f, 0.f, 0.f, 0.f}, b1 = b0;
            if (MODE >= 2) { b0 = *(const f32x4*)(bias + col); b1 = *(const f32x4*)(bias + col + 4); }
#pragma unroll
            for (int ai = 0; ai < 2; ++ai)
#pragma unroll
                for (int m = 0; m < 4; ++m) {
                    bf16_t* rowp = O + (size_t)(row0 + ai * 128 + m * 16) * ldc + col;
                    float v[8];
#pragma unroll
                    for (int j = 0; j < 4; ++j) { v[j] = acc[ai][bj][m][0][j] + b0[j]; v[4 + j] = acc[ai][bj][m][1][j] + b1[j]; }
                    u32x4 w;
                    if (MODE == 1) {
#pragma unroll
                        for (int j = 0; j < 8; ++j) {
                            float x = v[j];
                            if (col < 64) { const float e = fast_exp(-2.0f * fabsf(x)); const float th = (1.0f - e) * fast_rcp(1.0f + e); x = x < 0.f ? -th : th; }
                            else if (col < 128) { }
                            else if (col < 288) x = sigmoidf_(x);
                            else x = 0.f;
                            v[j] = x;
                        }
                    }
                    if (MODE == 3) {
#pragma unroll
                        for (int j = 0; j < 8; ++j) v[j] = sigmoidf_(v[j]);
                    }
                    if (MODE == 2) {
                        unsigned hw[4];
#pragma unroll
                        for (int j = 0; j < 4; ++j) {
                            float om[2];
#pragma unroll
                            for (int q = 0; q < 2; ++q) { const float x = v[2 * j + q];
                                const float e = 0.6065306597f * sigmoidf_(x); om[q] = 1.0f - fast_exp(-e); }
                            h16x2 hh; hh.x = (_Float16)om[0]; hh.y = (_Float16)om[1]; hw[j] = __builtin_bit_cast(unsigned, hh);
                        }
                        w.x = hw[0]; w.y = hw[1]; w.z = hw[2]; w.w = hw[3];
                    } else { w.x = cvt_pk_bf16(v[0], v[1]); w.y = cvt_pk_bf16(v[2], v[3]); w.z = cvt_pk_bf16(v[4], v[5]); w.w = cvt_pk_bf16(v[6], v[7]); }
                    *(u32x4*)rowp = w;
                    if (MODE != 0) asm volatile("" ::: "memory");
                }
        }
    }
};

template <class Epi> DI void run_gemm(const int wv_, LAS unsigned char* lds, const bf16_t* A, const bf16_t* Bt, int N, int K, int lda, int ldb, int gapA, const Epi& E, int G_ = -1, int c_ = 0) {
    pg8::Gemm g; g.A = A; g.Bt = Bt; g.M = T_TOK; g.N = N; g.K = K; g.lda = lda; g.ldb = ldb; g.gapA = gapA;
    pg8::StaticOrder S; if (G_ < 0) S.init(T_TOK, N, my_nblk(), my_bid()); else S.init(T_TOK, N, G_, c_);
    pg8::gemm_phase<Epi>(wv_, lds, g, S, E);
    __syncthreads();
}

struct ConvJob { const float* src; const float* scale; bf16_t* dst; int Ks, Ns, ldd, rb, NR, r0, cb, NC, c0, flags; int pad_; };
DI void conv_phase(const int wv_, const ConvJob* jobs, int j0, int j1, LAS unsigned char* lds, int G_ = -1, int c_ = 0) {
    LAS float* tile = (LAS float*)lds;
    const int tid = my_tid();
    int total = 0;
    for (int j = j0; j < j1; ++j) total += ((jobs[j].NR + 255) >> 8) * (jobs[j].NC >> 6);
    const int cstart = G_ < 0 ? my_bid() : c_, cstep = G_ < 0 ? my_nblk() : G_;
    for (int t = cstart; t < total; t += cstep) {
        int j = j0, tt = t;
        for (;; ++j) { const int nt = ((jobs[j].NR + 255) >> 8) * (jobs[j].NC >> 6); if (tt < nt) break; tt -= nt; }
        const ConvJob J = jobs[j];
        const int ntr = (J.NR + 255) >> 8; const int tr = tt % ntr, tc = tt / ntr;
        const int nrel0 = tr * 256, c0t = J.cb + tc * 64;
        const int smode = (J.flags >> 1) & 3;
#pragma unroll
        for (int q = 0; q < 8; ++q) {
            const int i = tid + q * 512, kl = i >> 6, n4 = i & 63;
            const int k = c0t + kl - J.c0, nrel = nrel0 + n4 * 4, n = J.rb + nrel - J.r0;
            f32x4 v = {0.f, 0.f, 0.f, 0.f};
            if (J.src != nullptr && k >= 0 && k < J.Ks && n >= 0 && n < J.Ns && nrel < J.NR) {
                v = *(const f32x4*)(J.src + (size_t)k * J.Ns + n);
                if (smode == 1) v = v * J.scale[k]; else if (smode == 2) v = v * (1.0f - J.scale[k]);
            }
            *(LAS f32x4*)(tile + kl * 260 + n4 * 4) = v;
        }
        __syncthreads();
#pragma unroll
        for (int q = 0; q < 4; ++q) {
            const int p = tid + q * 512, nl = p & 255, seg = p >> 8;
            const int nrel = nrel0 + nl;
            if (nrel < J.NR) {
                const LAS float* tp = tile + (8 * seg) * 260 + nl;
                u32x4 w; w.x = cvt_pk_bf16(tp[0], tp[260]); w.y = cvt_pk_bf16(tp[2 * 260], tp[3 * 260]); w.z = cvt_pk_bf16(tp[4 * 260], tp[5 * 260]); w.w = cvt_pk_bf16(tp[6 * 260], tp[7 * 260]);
                const int row = J.rb + ((J.flags & 1) ? ((nrel >> 7) * 256 + (nrel & 127)) : nrel);
                *(u32x4*)(J.dst + (size_t)row * J.ldd + c0t + 8 * seg) = w;
            }
        }
        __syncthreads();
    }
}

template <bool XBF> DI void norm_phase(const int wv_, const void* X, const float* g, bf16_t* out, int gap) {
    const int wave = my_bid() * 8 + (my_tid() >> 6), lane = my_tid() & 63, nw = my_nblk() * 8;
    f32x4 gv[4];
#pragma unroll
    for (int i = 0; i < 4; ++i) gv[i] = *(const f32x4*)(g + i * 256 + lane * 4);
    for (int row = wave; row < T_TOK; row += nw) {
        f32x4 v[4]; float ss = 0.f;
#pragma unroll
        for (int i = 0; i < 4; ++i) { v[i] = ldx4<XBF>(X, (size_t)row * DM + i * 256 + lane * 4); ss += v[i][0] * v[i][0] + v[i][1] * v[i][1] + v[i][2] * v[i][2] + v[i][3] * v[i][3]; }
#pragma unroll
        for (int o = 32; o >= 1; o >>= 1) ss += __shfl_xor(ss, o);
        const float rs = rsqrtf(ss * (1.0f / 1024.0f) + 1e-6f);
        const size_t orow = gap ? (size_t)row + (row >> 12) + 1 : (size_t)row;
        bf16_t* op = out + orow * DM;
#pragma unroll
        for (int i = 0; i < 4; ++i) { u32x2 w; w.x = cvt_pk_bf16(v[i][0] * rs * gv[i][0], v[i][1] * rs * gv[i][1]); w.y = cvt_pk_bf16(v[i][2] * rs * gv[i][2], v[i][3] * rs * gv[i][3]);
            *(u32x2*)(op + i * 256 + lane * 4) = w; }
        if (gap && (row & 4095) == 0) {
            bf16_t* zp = out + (orow - 1) * DM;
#pragma unroll
            for (int i = 0; i < 4; ++i) *(u32x2*)(zp + i * 256 + lane * 4) = (u32x2){0u, 0u};
        }
    }
}

DI void normmix_phase(const int wv_, const bf16_t* X, const float* g, const float* mix, bf16_t* hgap, bf16_t* xr, bf16_t* xk, bf16_t* xv) {
    const int wave = my_bid() * 8 + (my_tid() >> 6), lane = my_tid() & 63, nw = my_nblk() * 8;
    f32x4 gv[4], mr[4], mk[4], mv[4];
#pragma unroll
    for (int i = 0; i < 4; ++i) { gv[i] = *(const f32x4*)(g + i * 256 + lane * 4); mr[i] = *(const f32x4*)(mix + 0 * DM + i * 256 + lane * 4);
        mk[i] = *(const f32x4*)(mix + 2 * DM + i * 256 + lane * 4); mv[i] = *(const f32x4*)(mix + 3 * DM + i * 256 + lane * 4); }
    constexpr int R = 4;
    for (int row0 = wave * R; row0 < T_TOK; row0 += nw * R) {
        const bool first = (row0 & 4095) == 0;
        f32x4 v[R + 1][4]; float ss[R + 1];
#pragma unroll
        for (int i = 0; i < 4; ++i) v[0][i] = first ? (f32x4){0.f, 0.f, 0.f, 0.f} : ldx4<true>(X, (size_t)(row0 - 1) * DM + i * 256 + lane * 4);
#pragma unroll
        for (int r = 1; r <= R; ++r)
#pragma unroll
            for (int i = 0; i < 4; ++i) v[r][i] = ldx4<true>(X, (size_t)(row0 + r - 1) * DM + i * 256 + lane * 4);
#pragma unroll
        for (int r = 0; r <= R; ++r) { float s = 0.f;
#pragma unroll
            for (int i = 0; i < 4; ++i) s += v[r][i][0] * v[r][i][0] + v[r][i][1] * v[r][i][1] + v[r][i][2] * v[r][i][2] + v[r][i][3] * v[r][i][3];
            ss[r] = s; }
#pragma unroll
        for (int o = 32; o >= 1; o >>= 1)
#pragma unroll
            for (int r = 0; r <= R; ++r) ss[r] += __shfl_xor(ss[r], o);
        f32x4 hp[4];
        { const float rp = rsqrtf(ss[0] * (1.0f / 1024.0f) + 1e-6f);
#pragma unroll
          for (int i = 0; i < 4; ++i) hp[i] = v[0][i] * rp * gv[i]; }
#pragma unroll
        for (int r = 1; r <= R; ++r) {
            const int row = row0 + r - 1;
            const float rs = rsqrtf(ss[r] * (1.0f / 1024.0f) + 1e-6f);
            const size_t orow = (size_t)row + (row >> 12) + 1;
#pragma unroll
            for (int i = 0; i < 4; ++i) {
                const f32x4 h = v[r][i] * rs * gv[i], xx = hp[i] - h;
                const f32x4 a = h + xx * mr[i], b = h + xx * mk[i], c = h + xx * mv[i];
                hp[i] = h;
                const size_t co = (size_t)i * 256 + lane * 4;
                u32x2 w0; w0.x = cvt_pk_bf16(h[0], h[1]); w0.y = cvt_pk_bf16(h[2], h[3]); *(u32x2*)(hgap + orow * DM + co) = w0;
                u32x2 w1; w1.x = cvt_pk_bf16(a[0], a[1]); w1.y = cvt_pk_bf16(a[2], a[3]); *(u32x2*)(xr + (size_t)row * DM + co) = w1;
                u32x2 w2; w2.x = cvt_pk_bf16(b[0], b[1]); w2.y = cvt_pk_bf16(b[2], b[3]); *(u32x2*)(xk + (size_t)row * DM + co) = w2;
                u32x2 w3; w3.x = cvt_pk_bf16(c[0], c[1]); w3.y = cvt_pk_bf16(c[2], c[3]); *(u32x2*)(xv + (size_t)row * DM + co) = w3;
            }
        }
        if (first) {
            bf16_t* zp = hgap + ((size_t)row0 + (row0 >> 12)) * DM;
#pragma unroll
            for (int i = 0; i < 4; ++i) *(u32x2*)(zp + i * 256 + lane * 4) = (u32x2){0u, 0u};
        }
    }
}

#define MFMA16(a, b, c) __builtin_amdgcn_mfma_f32_16x16x32_bf16((a), (b), (c), 0, 0, 0)
constexpr int KPITCH = 72;
constexpr int VPITCH_SB = 136;
constexpr int VPITCH_DL = 264;

DI void sb_block(const int wv_, const bf16_t* P, bf16_t* merged, LAS unsigned char* lds, int b, int h, int qb) {
    LAS bf16_t* Ks = (LAS bf16_t*)lds;
    LAS bf16_t* Vt = (LAS bf16_t*)(lds + 128 * KPITCH * 2);
    const int tid = my_tid(), w = tid >> 6, lane = tid & 63, fr = lane & 15, fq = lane >> 4;
    const int qpos = qb * 128 + w * 16 + fr;
    const bf16_t* Pb = P + (size_t)b * SEQ * 3072;
    bf16x8 Qf[2];
#pragma unroll
    for (int ks = 0; ks < 2; ++ks) Qf[ks] = *(const bf16x8*)(Pb + (size_t)qpos * 3072 + h * 64 + ks * 32 + fq * 8);
    f32x4 o[4];
#pragma unroll
    for (int dt = 0; dt < 4; ++dt) o[dt] = (f32x4){0.f, 0.f, 0.f, 0.f};
    float carry = 0.f;
    LAS float* cslot = (LAS float*)(lds + 128 * KPITCH * 2 + 64 * VPITCH_SB * 2);
    for (int kb = qb; kb >= 0; --kb) {
        __syncthreads();
        if (kb < qb) {
            float cm = cslot[0];
#pragma unroll
            for (int i = 1; i < 8; ++i) cm = fmaxf(cm, cslot[i]);
            if (cm < -120.0f) break;
        }
#pragma unroll
        for (int i = 0; i < 2; ++i) {
            const int idx = tid + i * 512, key = idx >> 3, seg = idx & 7;
            const bf16_t* src = Pb + (size_t)(kb * 128 + key) * 3072 + h * 64 + seg * 8;
            const u32x4 kv = *(const u32x4*)(src + 256);
            const u32x4 vv = *(const u32x4*)(src + 512);
            *(LAS u32x4*)(Ks + key * KPITCH + seg * 8) = kv;
            LAS bf16_t* vp = Vt + (seg * 8) * VPITCH_SB + key;
            vp[0 * VPITCH_SB] = (bf16_t)(vv.x & 0xffff); vp[1 * VPITCH_SB] = (bf16_t)(vv.x >> 16);
            vp[2 * VPITCH_SB] = (bf16_t)(vv.y & 0xffff); vp[3 * VPITCH_SB] = (bf16_t)(vv.y >> 16);
            vp[4 * VPITCH_SB] = (bf16_t)(vv.z & 0xffff); vp[5 * VPITCH_SB] = (bf16_t)(vv.z >> 16);
            vp[6 * VPITCH_SB] = (bf16_t)(vv.w & 0xffff); vp[7 * VPITCH_SB] = (bf16_t)(vv.w >> 16);
        }
        __syncthreads();
        f32x4 z[8];
#pragma unroll
        for (int kt = 0; kt < 8; ++kt) {
            z[kt] = (f32x4){0.f, 0.f, 0.f, 0.f};
#pragma unroll
            for (int ks = 0; ks < 2; ++ks) { const bf16x8 a = *(const LAS bf16x8*)(Ks + (kt * 16 + fr) * KPITCH + ks * 32 + fq * 8); z[kt] = MFMA16(a, Qf[ks], z[kt]); }
        }
        f32x4 lk[8]; float G[8];
        const int kbase = kb * 128 + 4 * fq;
#pragma unroll
        for (int kt = 0; kt < 8; ++kt) {
            float gs = 0.f;
#pragma unroll
            for (int j = 0; j < 4; ++j) {
                const float zz = z[kt][j] * 0.125f; z[kt][j] = zz;
                const float sp = fmaxf(zz, 0.f) + fast_log(1.0f + fast_exp(-fabsf(zz)));
                const bool valid = (kbase + kt * 16 + j) < qpos;
                const float l = valid ? -sp : 0.f; lk[kt][j] = l; gs += l;
            }
            G[kt] = gs;
        }
        float run = carry;
        bf16x8 Pf[4]; unsigned pw[16];
#pragma unroll
        for (int kt = 7; kt >= 0; --kt) {
            const float g0 = G[kt], b1 = __shfl_xor(g0, 16), c = g0 + b1, d = __shfl_xor(c, 32), tt = c + d;
            const float base = run + ((fq & 1) ? 0.f : b1) + ((fq & 2) ? 0.f : d);
            const float a3 = base, a2 = a3 + lk[kt][3], a1 = a2 + lk[kt][2], a0 = a1 + lk[kt][1];
            const float af[4] = {a0, a1, a2, a3};
            float wv[4];
#pragma unroll
            for (int j = 0; j < 4; ++j) { const bool valid = (kbase + kt * 16 + j) < qpos; wv[j] = valid ? fast_exp(z[kt][j] + lk[kt][j] + af[j]) : 0.f; }
            pw[2 * kt] = cvt_pk_bf16(wv[0], wv[1]); pw[2 * kt + 1] = cvt_pk_bf16(wv[2], wv[3]);
            run += tt;
        }
        carry = run;
        {
            float cm = carry;
            cm = fmaxf(cm, __shfl_xor(cm, 1)); cm = fmaxf(cm, __shfl_xor(cm, 2)); cm = fmaxf(cm, __shfl_xor(cm, 4)); cm = fmaxf(cm, __shfl_xor(cm, 8));
            cm = fmaxf(cm, __shfl_xor(cm, 16)); cm = fmaxf(cm, __shfl_xor(cm, 32));
            if (lane == 0) cslot[w] = cm;
        }
#pragma unroll
        for (int kp = 0; kp < 4; ++kp) { u32x4 pp; pp.x = pw[4 * kp]; pp.y = pw[4 * kp + 1]; pp.z = pw[4 * kp + 2]; pp.w = pw[4 * kp + 3]; Pf[kp] = __builtin_bit_cast(bf16x8, pp); }
#pragma unroll
        for (int dt = 0; dt < 4; ++dt)
#pragma unroll
            for (int kp = 0; kp < 4; ++kp) {
                const LAS bf16_t* vr = Vt + (dt * 16 + fr) * VPITCH_SB + 32 * kp + 4 * fq;
                const s16x4 lo = *(const LAS s16x4*)vr, hi = *(const LAS s16x4*)(vr + 16);
                const bf16x8 a = __builtin_shufflevector(lo, hi, 0, 1, 2, 3, 4, 5, 6, 7);
                o[dt] = MFMA16(a, Pf[kp], o[dt]);
            }
    }
    bf16_t* op = merged + ((size_t)b * SEQ + qpos) * 512 + h * 64 + 4 * fq;
#pragma unroll
    for (int dt = 0; dt < 4; ++dt) { u32x2 wv; wv.x = cvt_pk_bf16(o[dt][0], o[dt][1]); wv.y = cvt_pk_bf16(o[dt][2], o[dt][3]); *(u32x2*)(op + dt * 16) = wv; }
}

DI int t5_bucket(int dist) {
    if (dist < 16) return dist;
    const float d = (float)dist;
    int large = 16 + (int)(logf(d / 16.0f) / 4.852030263919617f * 16.0f);
    return large < 31 ? large : 31;
}

DI void dil_block(const int wv_, const bf16_t* P, bf16_t* og, float* lse, const float* rel_bias, const float* qn, const float* kn, LAS unsigned char* lds, int b, int g, int j, int c, int n) {
    LAS bf16_t* Ks = (LAS bf16_t*)lds;
    LAS bf16_t* Vt = (LAS bf16_t*)(lds + 256 * KPITCH * 2);
    LAS float* biasv = (LAS float*)(lds + 256 * KPITCH * 2 + 64 * VPITCH_DL * 2);
    const int tid = my_tid(), w = tid >> 6, lane = tid & 63, fr = lane & 15, fq = lane >> 4;
    const int r = (g == 0) ? 1 : (g == 1 ? 4 : 16);
    const int hd = 4 * g + j;
    const bf16_t* Pb = P + (size_t)b * SEQ * 3072;
    __syncthreads();
#pragma unroll
    for (int i = 0; i < 4; ++i) {
        const int idx = tid + i * 512, key = idx >> 3, seg = idx & 7;
        const int m = 128 * (n - 1) + key;
        u32x4 kv = (u32x4){0u, 0u, 0u, 0u}, vv = kv;
        if (m >= 0) { const bf16_t* src = Pb + (size_t)(m * r + c) * 3072 + hd * 64 + seg * 8; kv = *(const u32x4*)(src + 1536); vv = *(const u32x4*)(src + 2304); }
        float kf[8] = {bf_lo(kv.x), bf_hi(kv.x), bf_lo(kv.y), bf_hi(kv.y), bf_lo(kv.z), bf_hi(kv.z), bf_lo(kv.w), bf_hi(kv.w)};
        float ss = 0.f;
#pragma unroll
        for (int e = 0; e < 8; ++e) ss += kf[e] * kf[e];
        ss += __shfl_xor(ss, 1); ss += __shfl_xor(ss, 2); ss += __shfl_xor(ss, 4);
        const float rs = rsqrtf(ss * (1.0f / 64.0f) + 1e-6f);
        const f32x4 n0 = *(const f32x4*)(kn + seg * 8), n1 = *(const f32x4*)(kn + seg * 8 + 4);
        u32x4 ko;
        ko.x = cvt_pk_bf16(kf[0] * rs * n0[0], kf[1] * rs * n0[1]); ko.y = cvt_pk_bf16(kf[2] * rs * n0[2], kf[3] * rs * n0[3]);
        ko.z = cvt_pk_bf16(kf[4] * rs * n1[0], kf[5] * rs * n1[1]); ko.w = cvt_pk_bf16(kf[6] * rs * n1[2], kf[7] * rs * n1[3]);
        *(LAS u32x4*)(Ks + key * KPITCH + seg * 8) = ko;
        LAS bf16_t* vp = Vt + (seg * 8) * VPITCH_DL + key;
        vp[0 * VPITCH_DL] = (bf16_t)(vv.x & 0xffff); vp[1 * VPITCH_DL] = (bf16_t)(vv.x >> 16);
        vp[2 * VPITCH_DL] = (bf16_t)(vv.y & 0xffff); vp[3 * VPITCH_DL] = (bf16_t)(vv.y >> 16);
        vp[4 * VPITCH_DL] = (bf16_t)(vv.z & 0xffff); vp[5 * VPITCH_DL] = (bf16_t)(vv.z >> 16);
        vp[6 * VPITCH_DL] = (bf16_t)(vv.w & 0xffff); vp[7 * VPITCH_DL] = (bf16_t)(vv.w >> 16);
    }
    if (tid < 132) { const int dd = tid < 128 ? tid : 128; biasv[tid] = rel_bias[t5_bucket(dd * r) * 12 + hd]; }
    const int qi = w * 16 + fr;
    const int tq = (128 * n + qi) * r + c;
    bf16x8 Qf[2];
    {
        u32x4 qv[2]; float ss = 0.f; float qf[16];
#pragma unroll
        for (int ks = 0; ks < 2; ++ks) { qv[ks] = *(const u32x4*)(Pb + (size_t)tq * 3072 + 768 + hd * 64 + ks * 32 + fq * 8);
            qf[ks * 8 + 0] = bf_lo(qv[ks].x); qf[ks * 8 + 1] = bf_hi(qv[ks].x); qf[ks * 8 + 2] = bf_lo(qv[ks].y); qf[ks * 8 + 3] = bf_hi(qv[ks].y);
            qf[ks * 8 + 4] = bf_lo(qv[ks].z); qf[ks * 8 + 5] = bf_hi(qv[ks].z); qf[ks * 8 + 6] = bf_lo(qv[ks].w); qf[ks * 8 + 7] = bf_hi(qv[ks].w); }
#pragma unroll
        for (int e = 0; e < 16; ++e) ss += qf[e] * qf[e];
        ss += __shfl_xor(ss, 16); ss += __shfl_xor(ss, 32);
        const float rs = rsqrtf(ss * (1.0f / 64.0f) + 1e-6f);
#pragma unroll
        for (int ks = 0; ks < 2; ++ks) {
            const f32x4 n0 = *(const f32x4*)(qn + ks * 32 + fq * 8), n1 = *(const f32x4*)(qn + ks * 32 + fq * 8 + 4);
            u32x4 qo;
            qo.x = cvt_pk_bf16(qf[ks * 8 + 0] * rs * n0[0], qf[ks * 8 + 1] * rs * n0[1]); qo.y = cvt_pk_bf16(qf[ks * 8 + 2] * rs * n0[2], qf[ks * 8 + 3] * rs * n0[3]);
            qo.z = cvt_pk_bf16(qf[ks * 8 + 4] * rs * n1[0], qf[ks * 8 + 5] * rs * n1[1]); qo.w = cvt_pk_bf16(qf[ks * 8 + 6] * rs * n1[2], qf[ks * 8 + 7] * rs * n1[3]);
            Qf[ks] = __builtin_bit_cast(bf16x8, qo);
        }
    }
    __syncthreads();
    f32x4 s[9];
#pragma unroll
    for (int kt = 0; kt < 9; ++kt) {
        s[kt] = (f32x4){0.f, 0.f, 0.f, 0.f};
#pragma unroll
        for (int ks = 0; ks < 2; ++ks) { const bf16x8 a = *(const LAS bf16x8*)(Ks + ((w + kt) * 16 + fr) * KPITCH + ks * 32 + fq * 8); s[kt] = MFMA16(a, Qf[ks], s[kt]); }
    }
    float mx = -1e30f;
#pragma unroll
    for (int kt = 0; kt < 9; ++kt)
#pragma unroll
        for (int jj = 0; jj < 4; ++jj) {
            const int key = 16 * (w + kt) + 4 * fq + jj, kj = key - 128, dist = qi - kj;
            const bool valid = (dist >= 0) && (dist <= 128) && (n > 0 || kj >= 0);
            const int di = dist < 0 ? 0 : (dist > 128 ? 128 : dist);
            const float v = valid ? (s[kt][jj] * 0.125f + biasv[di]) : -1e30f;
            s[kt][jj] = v; mx = fmaxf(mx, v);
        }
    mx = fmaxf(mx, __shfl_xor(mx, 16)); mx = fmaxf(mx, __shfl_xor(mx, 32));
    float den = 0.f;
    bf16x8 Pf[5]; unsigned pw[20];
#pragma unroll
    for (int kt = 0; kt < 9; ++kt) {
        float pv[4];
#pragma unroll
        for (int jj = 0; jj < 4; ++jj) { const float v = s[kt][jj]; const float p = (v > -1e29f) ? fast_exp(v - mx) : 0.f; pv[jj] = p; den += p; }
        pw[2 * kt] = cvt_pk_bf16(pv[0], pv[1]); pw[2 * kt + 1] = cvt_pk_bf16(pv[2], pv[3]);
    }
    pw[18] = 0u; pw[19] = 0u;
#pragma unroll
    for (int kp = 0; kp < 5; ++kp) { u32x4 pp; pp.x = pw[4 * kp]; pp.y = pw[4 * kp + 1]; pp.z = pw[4 * kp + 2]; pp.w = pw[4 * kp + 3]; Pf[kp] = __builtin_bit_cast(bf16x8, pp); }
    den += __shfl_xor(den, 16); den += __shfl_xor(den, 32);
    f32x4 o[4];
#pragma unroll
    for (int dt = 0; dt < 4; ++dt) {
        o[dt] = (f32x4){0.f, 0.f, 0.f, 0.f};
#pragma unroll
        for (int kp = 0; kp < 5; ++kp) {
            const LAS bf16_t* vr = Vt + (dt * 16 + fr) * VPITCH_DL + 16 * (w + 2 * kp) + 4 * fq;
            const s16x4 lo = *(const LAS s16x4*)vr;
            s16x4 hi = (s16x4){0, 0, 0, 0};
            if (kp < 4) hi = *(const LAS s16x4*)(vr + 16);
            const bf16x8 a = __builtin_shufflevector(lo, hi, 0, 1, 2, 3, 4, 5, 6, 7);
            o[dt] = MFMA16(a, Pf[kp], o[dt]);
        }
    }
    const float inv = 1.0f / den;
    const size_t tok = (size_t)b * SEQ + tq;
    bf16_t* op = og + ((size_t)g * T_TOK + tok) * 256 + j * 64 + 4 * fq;
#pragma unroll
    for (int dt = 0; dt < 4; ++dt) { u32x2 wv; wv.x = cvt_pk_bf16(o[dt][0] * inv, o[dt][1] * inv); wv.y = cvt_pk_bf16(o[dt][2] * inv, o[dt][3] * inv); *(u32x2*)(op + dt * 16) = wv; }
    if (fq == 0) lse[((size_t)g * T_TOK + tok) * 4 + j] = mx + logf(den);
}

DI void attn_phase(const int wv_, const bf16_t* P, bf16_t* merged, bf16_t* og, float* lse, const float* rel_bias, const float* qn, const float* kn, LAS unsigned char* lds) {
    for (int it = my_bid(); it < 512; it += my_nblk()) {
        const int bh = it >> 4, pr = it & 15, b = bh >> 2, h = bh & 3;
        sb_block(wv_, P, merged, lds, b, h, 31 - pr);
        sb_block(wv_, P, merged, lds, b, h, pr);
    }
    for (int it = my_bid(); it < 3072; it += my_nblk()) {
        const int sbk = it & 31, j = (it >> 5) & 3, gb = it >> 7, g = gb % 3, b = gb / 3;
        const int r = (g == 0) ? 1 : (g == 1 ? 4 : 16);
        const int c = sbk % r, n = sbk / r;
        dil_block(wv_, P, og, lse, rel_bias, qn, kn, lds, b, g, j, c, n);
    }
}

DI void combine_phase(const int wv_, const bf16_t* og, const float* lse, bf16_t* merged) {
    const int nthr = my_nblk() * 512;
    for (int i = my_bid() * 512 + my_tid(); i < T_TOK * 32; i += nthr) {
        const int tok = i >> 5, j = (i >> 3) & 3, seg = i & 7;
        const float l0 = lse[(size_t)tok * 4 + j], l1 = lse[((size_t)T_TOK + tok) * 4 + j], l2 = lse[((size_t)2 * T_TOK + tok) * 4 + j];
        const float m = fmaxf(l0, fmaxf(l1, l2));
        float a0 = __expf(l0 - m), a1 = __expf(l1 - m), a2 = __expf(l2 - m);
        const float inv = 1.0f / (a0 + a1 + a2); a0 *= inv; a1 *= inv; a2 *= inv;
        const size_t off = (size_t)tok * 256 + j * 64 + seg * 8;
        const u32x4 x0 = *(const u32x4*)(og + off), x1 = *(const u32x4*)(og + (size_t)T_TOK * 256 + off), x2 = *(const u32x4*)(og + (size_t)2 * T_TOK * 256 + off);
        u32x4 r;
        r.x = cvt_pk_bf16(a0 * bf_lo(x0.x) + a1 * bf_lo(x1.x) + a2 * bf_lo(x2.x), a0 * bf_hi(x0.x) + a1 * bf_hi(x1.x) + a2 * bf_hi(x2.x));
        r.y = cvt_pk_bf16(a0 * bf_lo(x0.y) + a1 * bf_lo(x1.y) + a2 * bf_lo(x2.y), a0 * bf_hi(x0.y) + a1 * bf_hi(x1.y) + a2 * bf_hi(x2.y));
        r.z = cvt_pk_bf16(a0 * bf_lo(x0.z) + a1 * bf_lo(x1.z) + a2 * bf_lo(x2.z), a0 * bf_hi(x0.z) + a1 * bf_hi(x1.z) + a2 * bf_hi(x2.z));
        r.w = cvt_pk_bf16(a0 * bf_lo(x0.w) + a1 * bf_lo(x1.w) + a2 * bf_lo(x2.w), a0 * bf_hi(x0.w) + a1 * bf_hi(x1.w) + a2 * bf_hi(x2.w));
        *(u32x4*)(merged + (size_t)tok * 512 + 256 + j * 64 + seg * 8) = r;
    }
}

DI float dpp_sum16(float x) {
    x += __int_as_float(__builtin_amdgcn_update_dpp(0, __float_as_int(x), 0xB1, 0xf, 0xf, false));
    x += __int_as_float(__builtin_amdgcn_update_dpp(0, __float_as_int(x), 0x4E, 0xf, 0xf, false));
    x += __int_as_float(__builtin_amdgcn_update_dpp(0, __float_as_int(x), 0x124, 0xf, 0xf, false));
    x += __int_as_float(__builtin_amdgcn_update_dpp(0, __float_as_int(x), 0x128, 0xf, 0xf, false));
    return x;
}
constexpr int SC_STEP = 356;
constexpr int SC_CH = 32;
constexpr int SC_BUF = SC_CH * SC_STEP;

DI void scan_item(const int wv_, const bf16_t* Rg, const bf16_t* Kg, const bf16_t* Vg, const bf16_t* OMg, const bf16_t* Ag, bf16_t* Yg, float* bon,
                  const float* k_k, const float* k_a, const float* r_k, LAS unsigned char* lds, int b, int h, int half) {
    LAS float* buf = (LAS float*)lds;
    LAS float* ybuf = (LAS float*)(lds + 2 * SC_BUF * 4);
    const int tid = my_tid(), w = tid >> 6, lane = tid & 63, kq = lane & 15, rho = lane >> 4;
    const int st = tid >> 4, part = tid & 15;
    const int pc = part < 8 ? part : 0;
    float pkk[8], pka[8], prk[8];
#pragma unroll
    for (int e = 0; e < 8; ++e) { pkk[e] = k_k[h * 64 + pc * 8 + e]; pka[e] = k_a[h * 64 + pc * 8 + e]; prk[e] = r_k[h * 64 + pc * 8 + e]; }
    const size_t tok0 = (size_t)b * SEQ;
    u32x4 g_r, g_k, g_om, g_a;
    auto issue = [&](int chunk) __attribute__((always_inline)) {
        const size_t t = tok0 + chunk * SC_CH + st;
        const size_t o = t * DM + h * 64 + pc * 8;
        const bf16_t* p0 = (part < 8) ? (Rg + o) : (Vg + t * DM + h * 64 + half * 32 + (part & 3) * 8);
        g_r = *(const u32x4*)p0; g_k = *(const u32x4*)(Kg + o); g_om = *(const u32x4*)(OMg + o); g_a = *(const u32x4*)(Ag + o);
    };
    auto commit = [&](int chunk, LAS float* dst) __attribute__((always_inline)) {
        LAS float* sp = dst + st * SC_STEP;
        float kf[8], af[8], rf[8], of[8];
        const unsigned kw[4] = {g_k.x, g_k.y, g_k.z, g_k.w}, aw[4] = {g_a.x, g_a.y, g_a.z, g_a.w}, rw[4] = {g_r.x, g_r.y, g_r.z, g_r.w}, ow[4] = {g_om.x, g_om.y, g_om.z, g_om.w};
#pragma unroll
        for (int q = 0; q < 4; ++q) {
            kf[2 * q] = bf_lo(kw[q]); kf[2 * q + 1] = bf_hi(kw[q]); af[2 * q] = bf_lo(aw[q]); af[2 * q + 1] = bf_hi(aw[q]); rf[2 * q] = bf_lo(rw[q]); rf[2 * q + 1] = bf_hi(rw[q]);
            const h16x2 hh = __builtin_bit_cast(h16x2, ow[q]); of[2 * q] = (float)hh.x; of[2 * q + 1] = (float)hh.y;
        }
        float kkv[8], ss = 0.f;
#pragma unroll
        for (int e = 0; e < 8; ++e) { kkv[e] = kf[e] * pkk[e]; ss += kkv[e] * kkv[e]; }
        ss += __shfl_xor(ss, 1); ss += __shfl_xor(ss, 2); ss += __shfl_xor(ss, 4);
        const float inv = 1.0f / fmaxf(sqrtf(ss), 1e-12f);
        float Wv[8], Kv[8], Av[8], Bv[8], Qv[8], bo = 0.f, br = 0.f, kr = 0.f;
#pragma unroll
        for (int e = 0; e < 8; ++e) {
            const float kk = kkv[e] * inv;
            Av[e] = -kk; Bv[e] = kk * af[e]; Kv[e] = kf[e] * (1.0f + (af[e] - 1.0f) * pka[e]); Wv[e] = 1.0f - of[e]; Qv[e] = Wv[e] * rf[e];
            bo += rf[e] * Kv[e] * prk[e]; br += Bv[e] * rf[e]; kr += Kv[e] * rf[e];
        }
        bo += __shfl_xor(bo, 1); bo += __shfl_xor(bo, 2); bo += __shfl_xor(bo, 4);
        br += __shfl_xor(br, 1); br += __shfl_xor(br, 2); br += __shfl_xor(br, 4);
        kr += __shfl_xor(kr, 1); kr += __shfl_xor(kr, 2); kr += __shfl_xor(kr, 4);
        if (part < 8) {
            *(LAS f32x4*)(sp + 0 * 64 + part * 8) = (f32x4){Wv[0], Wv[1], Wv[2], Wv[3]}; *(LAS f32x4*)(sp + 0 * 64 + part * 8 + 4) = (f32x4){Wv[4], Wv[5], Wv[6], Wv[7]};
            *(LAS f32x4*)(sp + 1 * 64 + part * 8) = (f32x4){Kv[0], Kv[1], Kv[2], Kv[3]}; *(LAS f32x4*)(sp + 1 * 64 + part * 8 + 4) = (f32x4){Kv[4], Kv[5], Kv[6], Kv[7]};
            *(LAS f32x4*)(sp + 2 * 64 + part * 8) = (f32x4){Av[0], Av[1], Av[2], Av[3]}; *(LAS f32x4*)(sp + 2 * 64 + part * 8 + 4) = (f32x4){Av[4], Av[5], Av[6], Av[7]};
            *(LAS f32x4*)(sp + 3 * 64 + part * 8) = (f32x4){Bv[0], Bv[1], Bv[2], Bv[3]}; *(LAS f32x4*)(sp + 3 * 64 + part * 8 + 4) = (f32x4){Bv[4], Bv[5], Bv[6], Bv[7]};
            *(LAS f32x4*)(sp + 4 * 64 + part * 8) = (f32x4){Qv[0], Qv[1], Qv[2], Qv[3]}; *(LAS f32x4*)(sp + 4 * 64 + part * 8 + 4) = (f32x4){Qv[4], Qv[5], Qv[6], Qv[7]};
            if (part == 0) *(LAS f32x2*)(sp + 352) = (f32x2){br, kr};
            if (part == 0 && half == 0) bon[(tok0 + chunk * SC_CH + st) * 16 + h] = bo;
        } else if (part < 12) {
            const unsigned vw[4] = {g_r.x, g_r.y, g_r.z, g_r.w};
            *(LAS f32x4*)(sp + 320 + (part - 8) * 8) = (f32x4){bf_lo(vw[0]), bf_hi(vw[0]), bf_lo(vw[1]), bf_hi(vw[1])};
            *(LAS f32x4*)(sp + 320 + (part - 8) * 8 + 4) = (f32x4){bf_lo(vw[2]), bf_hi(vw[2]), bf_lo(vw[3]), bf_hi(vw[3])};
        }
    };
    auto flush = [&](int chunk) __attribute__((always_inline)) {
        if (part < 4) {
            const LAS float* yp = ybuf + (chunk & 1) * 1024 + st * 32 + part * 8;
            const f32x4 y0 = *(const LAS f32x4*)yp, y1 = *(const LAS f32x4*)(yp + 4);
            u32x4 o; o.x = cvt_pk_bf16(y0[0], y0[1]); o.y = cvt_pk_bf16(y0[2], y0[3]); o.z = cvt_pk_bf16(y1[0], y1[1]); o.w = cvt_pk_bf16(y1[2], y1[3]);
            *(u32x4*)(Yg + (tok0 + chunk * SC_CH + st) * DM + h * 64 + half * 32 + part * 8) = o;
        }
    };
    f32x2 S0 = (f32x2){0.f, 0.f}, S1 = (f32x2){0.f, 0.f};
    const int tid_ = tid;
    auto steps = [&](const LAS float* src, LAS float* yb, int ysel, int s0, int s1) __attribute__((always_inline)) {
        const LAS float* sp0 = src + 4 * kq; const LAS float* vp0 = src + 320 + 4 * w + rho;
        f32x4 w4 = *(const LAS f32x4*)(sp0 + s0 * SC_STEP), k4 = *(const LAS f32x4*)(sp0 + s0 * SC_STEP + 64), a4 = *(const LAS f32x4*)(sp0 + s0 * SC_STEP + 128),
              b4 = *(const LAS f32x4*)(sp0 + s0 * SC_STEP + 192), q4 = *(const LAS f32x4*)(sp0 + s0 * SC_STEP + 256);
        float vr = vp0[s0 * SC_STEP]; f32x2 bk = *(const LAS f32x2*)(src + s0 * SC_STEP + 352);
#pragma unroll 4
        for (int s = s0; s < s1; ++s) {
            const int sn = (s + 1 < SC_CH) ? s + 1 : s;
            const f32x4 nw4 = *(const LAS f32x4*)(sp0 + sn * SC_STEP), nk4 = *(const LAS f32x4*)(sp0 + sn * SC_STEP + 64), na4 = *(const LAS f32x4*)(sp0 + sn * SC_STEP + 128),
                        nb4 = *(const LAS f32x4*)(sp0 + sn * SC_STEP + 192), nq4 = *(const LAS f32x4*)(sp0 + sn * SC_STEP + 256);
            const float nvr = vp0[sn * SC_STEP]; const f32x2 nbk = *(const LAS f32x2*)(src + sn * SC_STEP + 352);
            const f32x2 a0 = {a4[0], a4[1]}, a1 = {a4[2], a4[3]}, q0 = {q4[0], q4[1]}, q1 = {q4[2], q4[3]};
            const f32x2 t1 = S0 * a0 + S1 * a1, t2 = S0 * q0 + S1 * q1;
            float p1 = t1[0] + t1[1], p2 = t2[0] + t2[1];
            p1 += __int_as_float(__builtin_amdgcn_update_dpp(0, __float_as_int(p1), 0xB1, 0xf, 0xf, false));
            p2 += __int_as_float(__builtin_amdgcn_update_dpp(0, __float_as_int(p2), 0xB1, 0xf, 0xf, false));
            p1 += __int_as_float(__builtin_amdgcn_update_dpp(0, __float_as_int(p1), 0x4E, 0xf, 0xf, false));
            p2 += __int_as_float(__builtin_amdgcn_update_dpp(0, __float_as_int(p2), 0x4E, 0xf, 0xf, false));
            p1 += __int_as_float(__builtin_amdgcn_update_dpp(0, __float_as_int(p1), 0x124, 0xf, 0xf, false));
            p2 += __int_as_float(__builtin_amdgcn_update_dpp(0, __float_as_int(p2), 0x124, 0xf, 0xf, false));
            p1 += __int_as_float(__builtin_amdgcn_update_dpp(0, __float_as_int(p1), 0x128, 0xf, 0xf, false));
            p2 += __int_as_float(__builtin_amdgcn_update_dpp(0, __float_as_int(p2), 0x128, 0xf, 0xf, false));
            const float sa = p1;
            const float y = p2 + sa * bk[0] + vr * bk[1];
            const f32x2 sa2 = {sa, sa}, vr2 = {vr, vr};
            const f32x2 w0 = {w4[0], w4[1]}, w1 = {w4[2], w4[3]}, b0 = {b4[0], b4[1]}, b1 = {b4[2], b4[3]}, k0 = {k4[0], k4[1]}, k1 = {k4[2], k4[3]};
            S0 = S0 * w0 + b0 * sa2 + k0 * vr2;
            S1 = S1 * w1 + b1 * sa2 + k1 * vr2;
            yb[ysel + s * 32] = y;
            w4 = nw4; k4 = nk4; a4 = na4; b4 = nb4; q4 = nq4; vr = nvr; bk = nbk;
        }
    };
    __syncthreads();
    issue(0); commit(0, buf);
    __syncthreads();
    constexpr int NCH = SEQ / SC_CH;
    for (int c = 0; c < NCH; ++c) {
        LAS float* cur = buf + (c & 1) * SC_BUF; LAS float* nxt = buf + ((c + 1) & 1) * SC_BUF; LAS float* yb = ybuf + (c & 1) * 1024;
        const int ysel = (kq == 0) ? (4 * w + rho) : (2048 - (c & 1) * 1024 + tid_);
        if (c + 1 < NCH) issue(c + 1);
        if (c > 0) flush(c - 1);
        steps(cur, yb, ysel, 0, SC_CH / 2);
        if (c + 1 < NCH) commit(c + 1, nxt);
        steps(cur, yb, ysel, SC_CH / 2, SC_CH);
        __syncthreads();
    }
    flush(NCH - 1);
}

constexpr int C2_AT = 0, C2_RT = 2304, C2_BT = 4608, C2_KT = 6912, C2_BK = 9216, C2_VT = 14336, C2_MK = 16384, C2_NR = 16896, C2_MR = 17408, C2_TT = 17920,
              C2_NF = 18432, C2_GC = 19456, C2_SLOT = 19712, C2_NBUF = 7, C2_NHELP = 6, C2_FLAGS = C2_SLOT * C2_NBUF;
DI float wave_sum64(float x) {
    x = dpp_sum16(x);
    const int xi = __float_as_int(x);
    const float s0 = __int_as_float(__builtin_amdgcn_readlane(xi, 0)), s1 = __int_as_float(__builtin_amdgcn_readlane(xi, 16)),
                s2 = __int_as_float(__builtin_amdgcn_readlane(xi, 32)), s3 = __int_as_float(__builtin_amdgcn_readlane(xi, 48));
    return (s0 + s1) + (s2 + s3);
}
DI unsigned short f2bf(float x) { return (unsigned short)(cvt_pk_bf16(x, 0.f) & 0xffffu); }
DI float bf2f(unsigned short u) { return __uint_as_float((unsigned)u << 16); }

DI void scan2_item(const int wv_, const bf16_t* Rg, const bf16_t* Kg, const bf16_t* Vg, const bf16_t* OMg, const bf16_t* Ag, bf16_t* Yg, float* bon,
                   const float* k_k, const float* k_a, const float* r_k, LAS unsigned char* lds, int b, int h) {
    const int tid = my_tid(), w = tid >> 6, lane = tid & 63, fr = lane & 15, fq = lane >> 4;
    LAS unsigned* flags = (LAS unsigned*)(lds + C2_FLAGS);
    const size_t tok0 = (size_t)b * SEQ;
    constexpr int NCH = SEQ / 16;
    __syncthreads();
    if (tid < 16) flags[tid] = 0u;
    __syncthreads();
    if (w >= 2) {
        const int c = lane;
        const float pkk = k_k[h * 64 + c], pka = k_a[h * 64 + c], prk = r_k[h * 64 + c];
        typedef unsigned short u16x2 __attribute__((ext_vector_type(2)));
        u16x2 nrk[16], noa[16]; unsigned short nvr[16];
        {
            const size_t base0 = (tok0 + (size_t)(w - 2) * 16) * DM + h * 64 + c;
#pragma unroll
            for (int t = 0; t < 16; ++t) { nrk[t].x = Rg[base0 + (size_t)t * DM]; nrk[t].y = Kg[base0 + (size_t)t * DM]; noa[t].x = OMg[base0 + (size_t)t * DM]; noa[t].y = Ag[base0 + (size_t)t * DM]; nvr[t] = Vg[base0 + (size_t)t * DM]; }
        }
        for (int ch = w - 2; ch < NCH; ch += C2_NHELP) {
            LAS unsigned char* slot = lds + (ch % C2_NBUF) * C2_SLOT;
            unsigned short rr[16], kr[16], orr[16], ar[16], vr[16];
#pragma unroll
            for (int t = 0; t < 16; ++t) { rr[t] = nrk[t].x; kr[t] = nrk[t].y; orr[t] = noa[t].x; ar[t] = noa[t].y; vr[t] = nvr[t]; }
            {
                const int chn = (ch + C2_NHELP < NCH) ? ch + C2_NHELP : ch;
                const size_t base = (tok0 + (size_t)chn * 16) * DM + h * 64 + c;
#pragma unroll
                for (int t = 0; t < 16; ++t) { nrk[t].x = Rg[base + (size_t)t * DM]; nrk[t].y = Kg[base + (size_t)t * DM]; noa[t].x = OMg[base + (size_t)t * DM]; noa[t].y = Ag[base + (size_t)t * DM]; nvr[t] = Vg[base + (size_t)t * DM]; }
            }
            if (ch >= C2_NBUF) {
                const unsigned need = (unsigned)(ch - C2_NBUF + 1);
                for (;;) {
                    const unsigned d0 = *(volatile LAS unsigned*)(flags + 8), d1 = *(volatile LAS unsigned*)(flags + 9);
                    if (d0 >= need && d1 >= need) break;
                    __builtin_amdgcn_s_sleep(1);
                }
                asm volatile("" ::: "memory");
            }
            LAS bf16_t* AT = (LAS bf16_t*)(slot + C2_AT); LAS bf16_t* RT = (LAS bf16_t*)(slot + C2_RT); LAS bf16_t* BT = (LAS bf16_t*)(slot + C2_BT); LAS bf16_t* KT = (LAS bf16_t*)(slot + C2_KT);
#pragma unroll
            for (int t = 0; t < 16; ++t) {
                const float kf = bf2f(kr[t]), af = bf2f(ar[t]), rf = bf2f(rr[t]);
                BT[t * 72 + c] = f2bf(kf * pkk); KT[t * 72 + c] = f2bf(kf * (1.0f + (af - 1.0f) * pka)); AT[t * 72 + c] = f2bf(rf * prk);
            }
            asm volatile("s_waitcnt lgkmcnt(0)" ::: "memory");
            {
                f32x4 g1 = {0.f, 0.f, 0.f, 0.f}, g2 = g1;
#pragma unroll
                for (int ks = 0; ks < 2; ++ks) {
                    const bf16x8 fB = *(const LAS bf16x8*)(BT + fr * 72 + ks * 32 + fq * 8), fK = *(const LAS bf16x8*)(KT + fr * 72 + ks * 32 + fq * 8), fA = *(const LAS bf16x8*)(AT + fr * 72 + ks * 32 + fq * 8);
                    g1 = MFMA16(fB, fB, g1); g2 = MFMA16(fK, fA, g2);
                }
                const int sel = fr & 3;
                const float ss = sel == 0 ? g1[0] : (sel == 1 ? g1[1] : (sel == 2 ? g1[2] : g1[3]));
                const float bo = sel == 0 ? g2[0] : (sel == 1 ? g2[1] : (sel == 2 ? g2[2] : g2[3]));
                if (fq == (fr >> 2)) {
                    *(LAS float*)(slot + C2_NF + fr * 4) = 1.0f / fmaxf(sqrtf(ss), 1e-12f);
                    bon[(tok0 + (size_t)ch * 16 + fr) * 16 + h] = bo;
                }
            }
            asm volatile("s_waitcnt lgkmcnt(0)" ::: "memory");
            float inv[16];
            {
                const LAS f32x4* ip = (const LAS f32x4*)(slot + C2_NF);
                const f32x4 i0 = ip[0], i1 = ip[1], i2 = ip[2], i3 = ip[3];
                const float tmp[16] = {i0[0], i0[1], i0[2], i0[3], i1[0], i1[1], i1[2], i1[3], i2[0], i2[1], i2[2], i2[3], i3[0], i3[1], i3[2], i3[3]};
#pragma unroll
                for (int t = 0; t < 16; ++t) inv[t] = tmp[t];
            }
            asm volatile("s_waitcnt lgkmcnt(0)" ::: "memory");
            float G = 1.0f; float bh[16], kh[16];
#pragma unroll
            for (int t = 0; t < 16; ++t) {
                const float kf = bf2f(kr[t]), af = bf2f(ar[t]), rf = bf2f(rr[t]);
                const float om = (float)__builtin_bit_cast(_Float16, orr[t]);
                const float kk = kf * pkk * inv[t];
                const float kp = kf * (1.0f + (af - 1.0f) * pka);
                const float wt = 1.0f - om;
                const float Gp = G; G *= wt;
                const float ig = fast_rcp(G);
                AT[t * 72 + c] = f2bf(-kk * Gp); RT[t * 72 + c] = f2bf(rf * G);
                bh[t] = kk * af * ig; kh[t] = kp * ig;
                BT[t * 72 + c] = f2bf(bh[t]); KT[t * 72 + c] = f2bf(kh[t]);
            }
            *(LAS float*)(slot + C2_GC + c * 4) = G;
#pragma unroll
            for (int q = 0; q < 4; ++q) {
                u32x4 wv4; wv4.x = cvt_pk_bf16(bh[4 * q] * G, bh[4 * q + 1] * G); wv4.y = cvt_pk_bf16(bh[4 * q + 2] * G, bh[4 * q + 3] * G);
                wv4.z = cvt_pk_bf16(kh[4 * q] * G, kh[4 * q + 1] * G); wv4.w = cvt_pk_bf16(kh[4 * q + 2] * G, kh[4 * q + 3] * G);
                *(LAS u32x4*)(slot + C2_BK + c * 80 + q * 16) = wv4;
            }
#pragma unroll
            for (int q = 0; q < 2; ++q) {
                u32x4 wv4; wv4.x = (unsigned)vr[8 * q] | ((unsigned)vr[8 * q + 1] << 16); wv4.y = (unsigned)vr[8 * q + 2] | ((unsigned)vr[8 * q + 3] << 16);
                wv4.z = (unsigned)vr[8 * q + 4] | ((unsigned)vr[8 * q + 5] << 16); wv4.w = (unsigned)vr[8 * q + 6] | ((unsigned)vr[8 * q + 7] << 16);
                *(LAS u32x4*)(slot + C2_VT + c * 32 + q * 16) = wv4;
            }
            asm volatile("s_waitcnt lgkmcnt(0)" ::: "memory");
            f32x4 cN = {0.f, 0.f, 0.f, 0.f}, cMk = cN, cNr = cN, cMr = cN;
#pragma unroll
            for (int ks = 0; ks < 2; ++ks) {
                const bf16x8 fB = *(const LAS bf16x8*)(BT + fr * 72 + ks * 32 + fq * 8), fK = *(const LAS bf16x8*)(KT + fr * 72 + ks * 32 + fq * 8);
                const bf16x8 fA = *(const LAS bf16x8*)(AT + fr * 72 + ks * 32 + fq * 8), fR = *(const LAS bf16x8*)(RT + fr * 72 + ks * 32 + fq * 8);
                cN = MFMA16(fB, fA, cN); cMk = MFMA16(fK, fA, cMk); cNr = MFMA16(fB, fR, cNr); cMr = MFMA16(fK, fR, cMr);
            }
#pragma unroll
            for (int jj = 0; jj < 4; ++jj) { const int j = 4 * fq + jj; if (!(j < fr)) { cN[jj] = 0.f; cMk[jj] = 0.f; } if (!(j <= fr)) { cNr[jj] = 0.f; cMr[jj] = 0.f; } }
            *(LAS f32x4*)(slot + C2_NF + (fr * 16 + 4 * fq) * 4) = cN;
            { u32x2 o; o.x = cvt_pk_bf16(cMk[0], cMk[1]); o.y = cvt_pk_bf16(cMk[2], cMk[3]); *(LAS u32x2*)(slot + C2_MK + (fr * 16 + 4 * fq) * 2) = o; }
            { u32x2 o; o.x = cvt_pk_bf16(cNr[0], cNr[1]); o.y = cvt_pk_bf16(cNr[2], cNr[3]); *(LAS u32x2*)(slot + C2_NR + (fr * 16 + 4 * fq) * 2) = o; }
            { u32x2 o; o.x = cvt_pk_bf16(cMr[0], cMr[1]); o.y = cvt_pk_bf16(cMr[2], cMr[3]); *(LAS u32x2*)(slot + C2_MR + (fr * 16 + 4 * fq) * 2) = o; }
            asm volatile("s_waitcnt lgkmcnt(0)" ::: "memory");
            float Tr[16];
#pragma unroll
            for (int t = 0; t < 16; ++t) {
                const LAS f32x4* nrow = (const LAS f32x4*)(slot + C2_NF + t * 64);
                const f32x4 n0 = nrow[0], n1 = nrow[1], n2 = nrow[2], n3 = nrow[3];
                const float nn[16] = {n0[0], n0[1], n0[2], n0[3], n1[0], n1[1], n1[2], n1[3], n2[0], n2[1], n2[2], n2[3], n3[0], n3[1], n3[2], n3[3]};
                float v0 = (fr == t) ? 1.0f : 0.0f, v1 = 0.f;
#pragma unroll
                for (int j = 0; j < t; ++j) { if (j & 1) v1 += Tr[j] * nn[j]; else v0 += Tr[j] * nn[j]; }
                Tr[t] = v0 + v1;
            }
            if (fq == 0) {
#pragma unroll
                for (int t = 0; t < 16; ++t) ((LAS bf16_t*)(slot + C2_TT))[t * 16 + fr] = f2bf(Tr[t]);
            }
            asm volatile("s_waitcnt lgkmcnt(0)" ::: "memory");
            if (lane == 0) *(volatile LAS unsigned*)(flags + (ch % C2_NBUF)) = (unsigned)(ch + 1);
        }
    } else {
        f32x4 acc[2][4];
#pragma unroll
        for (int i = 0; i < 2; ++i)
#pragma unroll
            for (int kt = 0; kt < 4; ++kt) acc[i][kt] = (f32x4){0.f, 0.f, 0.f, 0.f};
        const s16x4 z4 = {0, 0, 0, 0};
        for (int ch = 0; ch < NCH; ++ch) {
            LAS unsigned char* slot = lds + (ch % C2_NBUF) * C2_SLOT;
            while (*(volatile LAS unsigned*)(flags + (ch % C2_NBUF)) != (unsigned)(ch + 1)) __builtin_amdgcn_s_sleep(1);
            asm volatile("" ::: "memory");
            const LAS bf16_t* AT = (const LAS bf16_t*)(slot + C2_AT); const LAS bf16_t* RT = (const LAS bf16_t*)(slot + C2_RT);
            bf16x8 fa[2], fr2[2];
#pragma unroll
            for (int kp = 0; kp < 2; ++kp) {
                const s16x4 a0 = *(const LAS s16x4*)(AT + fr * 72 + 32 * kp + 4 * fq), a1 = *(const LAS s16x4*)(AT + fr * 72 + 32 * kp + 16 + 4 * fq);
                const s16x4 r0 = *(const LAS s16x4*)(RT + fr * 72 + 32 * kp + 4 * fq), r1 = *(const LAS s16x4*)(RT + fr * 72 + 32 * kp + 16 + 4 * fq);
                fa[kp] = __builtin_shufflevector(a0, a1, 0, 1, 2, 3, 4, 5, 6, 7); fr2[kp] = __builtin_shufflevector(r0, r1, 0, 1, 2, 3, 4, 5, 6, 7);
            }
            const s16x4 mk = *(const LAS s16x4*)(slot + C2_MK + (fr * 16 + 4 * fq) * 2), tt = *(const LAS s16x4*)(slot + C2_TT + (fr * 16 + 4 * fq) * 2);
            const s16x4 nr = *(const LAS s16x4*)(slot + C2_NR + (fr * 16 + 4 * fq) * 2), mr = *(const LAS s16x4*)(slot + C2_MR + (fr * 16 + 4 * fq) * 2);
            const bf16x8 fmk = __builtin_shufflevector(z4, mk, 0, 1, 2, 3, 4, 5, 6, 7), ftt = __builtin_shufflevector(tt, z4, 0, 1, 2, 3, 4, 5, 6, 7), fnm = __builtin_shufflevector(nr, mr, 0, 1, 2, 3, 4, 5, 6, 7);
            f32x4 g4[4]; bf16x8 bk[4];
#pragma unroll
            for (int kt = 0; kt < 4; ++kt) { g4[kt] = *(const LAS f32x4*)(slot + C2_GC + (16 * kt + 4 * fq) * 4); bk[kt] = *(const LAS bf16x8*)(slot + C2_BK + (16 * kt + fr) * 80 + fq * 16); }
            s16x4 Vf[2];
#pragma unroll
            for (int i = 0; i < 2; ++i) Vf[i] = *(const LAS s16x4*)(slot + C2_VT + (32 * w + 16 * i + fr) * 32 + 4 * fq * 2);
            asm volatile("s_waitcnt lgkmcnt(0)" ::: "memory");
            if (lane == 0) *(volatile LAS unsigned*)(flags + 8 + w) = (unsigned)(ch + 1);
            f32x4 yv[2];
#pragma unroll
            for (int i = 0; i < 2; ++i) {
                bf16x8 Sb[2];
#pragma unroll
                for (int kp = 0; kp < 2; ++kp) { u32x4 pk; pk.x = cvt_pk_bf16(acc[i][2 * kp][0], acc[i][2 * kp][1]); pk.y = cvt_pk_bf16(acc[i][2 * kp][2], acc[i][2 * kp][3]);
                    pk.z = cvt_pk_bf16(acc[i][2 * kp + 1][0], acc[i][2 * kp + 1][1]); pk.w = cvt_pk_bf16(acc[i][2 * kp + 1][2], acc[i][2 * kp + 1][3]); Sb[kp] = __builtin_bit_cast(bf16x8, pk); }
                f32x4 rhs = {0.f, 0.f, 0.f, 0.f}; yv[i] = (f32x4){0.f, 0.f, 0.f, 0.f};
#pragma unroll
                for (int kp = 0; kp < 2; ++kp) { rhs = MFMA16(fa[kp], Sb[kp], rhs); yv[i] = MFMA16(fr2[kp], Sb[kp], yv[i]); }
                rhs = MFMA16(fmk, __builtin_shufflevector(z4, Vf[i], 0, 1, 2, 3, 4, 5, 6, 7), rhs);
                u32x2 rp; rp.x = cvt_pk_bf16(rhs[0], rhs[1]); rp.y = cvt_pk_bf16(rhs[2], rhs[3]);
                f32x4 uv = {0.f, 0.f, 0.f, 0.f};
                uv = MFMA16(ftt, __builtin_shufflevector(__builtin_bit_cast(s16x4, rp), z4, 0, 1, 2, 3, 4, 5, 6, 7), uv);
                u32x2 up; up.x = cvt_pk_bf16(uv[0], uv[1]); up.y = cvt_pk_bf16(uv[2], uv[3]);
                const bf16x8 UVb = __builtin_shufflevector(__builtin_bit_cast(s16x4, up), Vf[i], 0, 1, 2, 3, 4, 5, 6, 7);
                yv[i] = MFMA16(fnm, UVb, yv[i]);
#pragma unroll
                for (int kt = 0; kt < 4; ++kt) acc[i][kt] = MFMA16(bk[kt], UVb, acc[i][kt] * g4[kt]);
            }
#pragma unroll
            for (int i = 0; i < 2; ++i) {
                bf16_t* yp = Yg + (tok0 + (size_t)ch * 16 + 4 * fq) * DM + h * 64 + 32 * w + 16 * i + fr;
#pragma unroll
                for (int jj = 0; jj < 4; ++jj) yp[(size_t)jj * DM] = f2bf(yv[i][jj]);
            }
        }
    }
    __syncthreads();
}

DI void post_phase(const int wv_, const bf16_t* Y, const bf16_t* Vg, bf16_t* G, const float* bon, const float* lng, const float* lnb) {
    const int nthr = my_nblk() * 512;
    for (int i = my_bid() * 512 + my_tid(); i < T_TOK * 128; i += nthr) {
        const int tok = i >> 7, cg8 = i & 127, hh = cg8 >> 3;
        const size_t off = (size_t)tok * DM + cg8 * 8;
        const u32x4 yv = *(const u32x4*)(Y + off), vv = *(const u32x4*)(Vg + off), gv = *(const u32x4*)(G + off);
        const float bo = bon[(size_t)tok * 16 + hh];
        float y[8] = {bf_lo(yv.x), bf_hi(yv.x), bf_lo(yv.y), bf_hi(yv.y), bf_lo(yv.z), bf_hi(yv.z), bf_lo(yv.w), bf_hi(yv.w)};
        const float v[8] = {bf_lo(vv.x), bf_hi(vv.x), bf_lo(vv.y), bf_hi(vv.y), bf_lo(vv.z), bf_hi(vv.z), bf_lo(vv.w), bf_hi(vv.w)};
        const float gg[8] = {bf_lo(gv.x), bf_hi(gv.x), bf_lo(gv.y), bf_hi(gv.y), bf_lo(gv.z), bf_hi(gv.z), bf_lo(gv.w), bf_hi(gv.w)};
        float s = 0.f;
#pragma unroll
        for (int e = 0; e < 8; ++e) s += y[e];
        s += __shfl_xor(s, 1); s += __shfl_xor(s, 2); s += __shfl_xor(s, 4);
        const float mu = s * (1.0f / 64.0f);
        float q = 0.f;
#pragma unroll
        for (int e = 0; e < 8; ++e) { const float d = y[e] - mu; q += d * d; }
        q += __shfl_xor(q, 1); q += __shfl_xor(q, 2); q += __shfl_xor(q, 4);
        const float rs = rsqrtf(q * (1.0f / 64.0f) + 64e-5f);
        const f32x4 g0 = *(const f32x4*)(lng + cg8 * 8), g1 = *(const f32x4*)(lng + cg8 * 8 + 4), c0 = *(const f32x4*)(lnb + cg8 * 8), c1 = *(const f32x4*)(lnb + cg8 * 8 + 4);
        const float lg[8] = {g0[0], g0[1], g0[2], g0[3], g1[0], g1[1], g1[2], g1[3]}, lb[8] = {c0[0], c0[1], c0[2], c0[3], c1[0], c1[1], c1[2], c1[3]};
        float o[8];
#pragma unroll
        for (int e = 0; e < 8; ++e) o[e] = ((y[e] - mu) * rs * lg[e] + lb[e] + bo * v[e]) * gg[e];
        u32x4 r; r.x = cvt_pk_bf16(o[0], o[1]); r.y = cvt_pk_bf16(o[2], o[3]); r.z = cvt_pk_bf16(o[4], o[5]); r.w = cvt_pk_bf16(o[6], o[7]);
        *(u32x4*)(G + off) = r;
    }
}


#define XB_TMO      128
#define XB_XCNT(j)  (256  + 64 * (j))
#define XB_XSUB(j)  (1280 + 64 * (j))
#define XB_XGEN(j)  (2304 + 64 * (j))
#define XB_TOP      3328
#define XB_TOPGEN   3392
#define XCD_BAR_WORDS 3456
#define XB_SPIN_CAP (1u << 18)
DI unsigned xb_ld(unsigned* p)              { return __hip_atomic_load(p, __ATOMIC_RELAXED, __HIP_MEMORY_SCOPE_AGENT); }
DI unsigned xb_add(unsigned* p, unsigned v) { return __hip_atomic_fetch_add(p, v, __ATOMIC_RELAXED, __HIP_MEMORY_SCOPE_AGENT); }
DI unsigned xb_xcc_id() { return (unsigned)__builtin_amdgcn_s_getreg((3 << 11) | 20) & 0xFu; }
#define XB_SPIN(cond, bar) do { unsigned _sp = 0; while (cond) { \
    if ((++_sp & 255u) == 0u) { if (xb_ld(&(bar)[XB_TMO])) break; if (_sp > XB_SPIN_CAP) { atomicAdd(&(bar)[XB_TMO], 1u); break; } } } } while (0)
DI void xcd_barrier_complete(unsigned* bar, unsigned x, unsigned G, unsigned& nloc, unsigned& nx) {
    unsigned sum, cnt, mine, sp = 0u;
    for (;;) {
        sum = 0u; cnt = 0u; mine = 0u;
#pragma unroll
        for (unsigned j = 0; j < 16; ++j) { const unsigned c = xb_ld(&bar[XB_XCNT(j)]); sum += c; cnt += (c > 0u) ? 1u : 0u; mine = (j == x) ? c : mine; }
        if (sum == G) break;
        __builtin_amdgcn_s_sleep(1);
        if ((++sp & 255u) == 0u) { if (xb_ld(&bar[XB_TMO])) break; if (sp > XB_SPIN_CAP) { atomicAdd(&bar[XB_TMO], 1u); break; } }
    }
    nloc = mine > 0u ? mine : 1u; nx = cnt > 0u ? cnt : 1u;
}
DI void xcd_barrier_(const int wv_, unsigned* bar, volatile LAS unsigned* st) {
    asm volatile("s_waitcnt vmcnt(0)" ::: "memory");
    __syncthreads();
    if (my_tid() == 0) {
        const unsigned x = xb_xcc_id();
        __builtin_amdgcn_s_waitcnt(0);
        unsigned nloc = st[0], nx = st[1];
        if (nloc == 0u) { xcd_barrier_complete(bar, x, (unsigned)my_nblk(), nloc, nx); st[0] = nloc; st[1] = nx; }
        const unsigned old = xb_add(&bar[XB_XSUB(x)], 1u);
        const unsigned gen = old / nloc;
        if (old + 1u == (gen + 1u) * nloc) {
            __builtin_amdgcn_fence(__ATOMIC_RELEASE, "agent");
            asm volatile("s_waitcnt vmcnt(0)" ::: "memory");
            const unsigned og = xb_add(&bar[XB_TOP], 1u);
            const unsigned tg = og / nx;
            if (og + 1u == (tg + 1u) * nx) xb_add(&bar[XB_TOPGEN], 1u);
            else XB_SPIN(xb_ld(&bar[XB_TOPGEN]) == tg, bar);
            __builtin_amdgcn_fence(__ATOMIC_ACQUIRE, "agent");
            xb_add(&bar[XB_XGEN(x)], 1u);
            asm volatile("s_waitcnt vmcnt(0)" ::: "memory");
        } else {
            XB_SPIN(xb_ld(&bar[XB_XGEN(x)]) == gen, bar);
            __builtin_amdgcn_fence(__ATOMIC_ACQUIRE, "agent");
            asm volatile("s_waitcnt vmcnt(0)" ::: "memory");
        }
    }
    __syncthreads();
}

constexpr int NJOBS = 28, JOB_PERSIST = 16;
struct Params {
    const float* in[29];
    float* out; unsigned char* ws;
    ConvJob jobs[NJOBS];
    int ph_lo, ph_hi; unsigned dup_mask; int pad2_;
};
constexpr int NPHASE = 24;

#ifdef DBG_NAN
DI bool bad_bf(unsigned short v) { return (v & 0x7f80) == 0x7f80; }
DI bool bad_f(float v) { return !(fabsf(v) <= 3.0e38f); }
DI void dbg_scan(const int wv_, const Params& p, unsigned* flags) {
    unsigned char* ws = p.ws;
    const bf16_t* Y0 = (const bf16_t*)(ws + WS_B7); const bf16_t* Y1 = (const bf16_t*)(ws + WS_B5);
    const float* b0 = (const float*)(ws + WS_BON); const float* b1 = (const float*)(ws + WS_LSE);
    const size_t gt = (size_t)my_bid() * 512 + my_tid(), nth = (size_t)my_nblk() * 512;
    float m0 = 0.f, md = 0.f, mb = 0.f, mbd = 0.f;
    for (size_t i = gt; i < (size_t)T_TOK * DM; i += nth) { const float a = bf2f(Y0[i]), c = bf2f(Y1[i]); const float d = fabsf(a - c); m0 = fmaxf(m0, fabsf(a)); md = (d == d) ? fmaxf(md, d) : 1e30f; }
    for (size_t i = gt; i < (size_t)T_TOK * 16; i += nth) { const float a = b0[i], c = b1[i]; const float d = fabsf(a - c); mb = fmaxf(mb, fabsf(a)); mbd = (d == d) ? fmaxf(mbd, d) : 1e30f; }
    atomicMax(flags + 0, __float_as_uint(m0)); atomicMax(flags + 1, __float_as_uint(md)); atomicMax(flags + 2, __float_as_uint(mb)); atomicMax(flags + 3, __float_as_uint(mbd));
}
#endif
DI void do_phase(const int wv_, const int ph, const Params& p, LAS unsigned char* lds) {
    unsigned char* ws = p.ws;
    bf16_t* HN = (bf16_t*)(ws + WS_HN); bf16_t* HID = (bf16_t*)(ws + WS_HID); bf16_t* GU = (bf16_t*)(ws + WS_GU); bf16_t* DN = (bf16_t*)(ws + WS_DN);
    bf16_t* PROJ = (bf16_t*)(ws + WS_PROJ); bf16_t* OG = (bf16_t*)(ws + WS_OG); bf16_t* MERGED = (bf16_t*)(ws + WS_MERGED); float* LSE = (float*)(ws + WS_LSE);
    bf16_t* B1 = (bf16_t*)(ws + WS_B1); bf16_t* B2 = (bf16_t*)(ws + WS_B2); bf16_t* B3 = (bf16_t*)(ws + WS_B3); bf16_t* B4 = (bf16_t*)(ws + WS_B4);
    bf16_t* B5 = (bf16_t*)(ws + WS_B5); bf16_t* B6 = (bf16_t*)(ws + WS_B6); bf16_t* B7 = (bf16_t*)(ws + WS_B7); float* BON = (float*)(ws + WS_BON);
    const float* x_in = p.in[0]; float* out = p.out; bf16_t* XS0 = (bf16_t*)p.out; bf16_t* XS1 = (bf16_t*)(ws + WS_XS1); bf16_t* YR = (bf16_t*)((unsigned char*)p.out + 64 * MiB); bf16_t* GU2 = (bf16_t*)(ws + WS_GU2); bf16_t* DN2 = (bf16_t*)(ws + WS_DN2);
    {
        switch (ph) {
        case 0: conv_phase(wv_, p.jobs, 0, JOB_PERSIST + 3, lds); norm_phase<false>(wv_, x_in, p.in[1] + 0 * DM, HN, 0); break;
        case 1: case 9: case 12: { EpiSwiGLU E; E.H = HID; run_gemm(wv_, lds, HN, GU, 2 * DFF, DM, DM, DM, 0, E); } break;
        case 22: { EpiSwiGLU E; E.H = HID; run_gemm(wv_, lds, HN, GU2, 2 * DFF, DM, DM, DM, 0, E); } break;
        case 2: { EpiResid<false, true> E; E.X = x_in; E.O = XS0; E.scale = 0.5f; run_gemm(wv_, lds, HID, DN, DM, DFF, DFF, DFF, 0, E); } break;
        case 10: case 13: { EpiResid<true, true> E; E.X = XS0; E.O = XS0; E.scale = 0.5f; run_gemm(wv_, lds, HID, DN, DM, DFF, DFF, DFF, 0, E); } break;
        case 23: { EpiResid<true, false> E; E.X = XS1; E.O = out; E.scale = 0.5f; run_gemm(wv_, lds, HID, DN2, DM, DFF, DFF, DFF, 0, E); } break;
        case 3: conv_phase(wv_, p.jobs, JOB_PERSIST + 3, JOB_PERSIST + 6, lds); norm_phase<true>(wv_, XS0, p.in[5] + 0 * DM, HN, 0); break;
        case 4: { EpiBf16<0> E; E.O = PROJ; E.ldc = 3072; E.bias = nullptr; run_gemm(wv_, lds, HN, (const bf16_t*)(ws + WS_WIN), 3072, DM, DM, DM, 0, E); } break;
        case 5: attn_phase(wv_, PROJ, MERGED, OG, LSE, p.in[6], p.in[8], p.in[9], lds); break;
        case 6: combine_phase(wv_, OG, LSE, MERGED); break;
        case 7: { EpiResid<true, true> E; E.X = XS0; E.O = XS0; E.scale = 1.0f; run_gemm(wv_, lds, MERGED, (const bf16_t*)(ws + WS_WOUT), DM, 512, 512, 512, 0, E); } break;
        case 8: norm_phase<true>(wv_, XS0, p.in[1] + 1 * DM, HN, 0); break;
        case 11: conv_phase(wv_, p.jobs, JOB_PERSIST + 6, JOB_PERSIST + 9, lds); norm_phase<true>(wv_, XS0, p.in[1] + 2 * DM, HN, 0); break;
        case 14: normmix_phase(wv_, XS0, p.in[5] + 1 * DM, p.in[11], B1, B2, B3, B4); break;
        case 15: {
            EpiBf16<0> E; E.ldc = DM; E.bias = nullptr;
            E.O = B5; run_gemm(wv_, lds, B2, (const bf16_t*)(ws + WS_WR), DM, DM, DM, DM, 0, E);
            E.O = B6; run_gemm(wv_, lds, B3, (const bf16_t*)(ws + WS_WK), DM, DM, DM, DM, 0, E);
            EpiBf16<1> E1; E1.O = B7; E1.ldc = 512; E1.bias = nullptr; run_gemm(wv_, lds, B1, (const bf16_t*)(ws + WS_L1), 512, 2048, DM, 2048, 2048, E1);
        } break;
        case 16: {
            EpiBf16<0> E; E.ldc = DM; E.bias = nullptr;
            E.O = B2; run_gemm(wv_, lds, B4, (const bf16_t*)(ws + WS_WV), DM, DM, DM, DM, 0, E);
            EpiBf16<2> Ew; Ew.O = B3; Ew.ldc = DM; Ew.bias = p.in[12]; run_gemm(wv_, lds, B7, (const bf16_t*)(ws + WS_L2W), DM, 128, 512, 128, 0, Ew);
            EpiBf16<3> Ea; Ea.O = YR; Ea.ldc = DM; Ea.bias = p.in[15]; run_gemm(wv_, lds, B7, (const bf16_t*)(ws + WS_L2A), DM, 128, 512, 128, 0, Ea);
        } break;
        case 18:
#ifdef SCAN_DEBUG
            for (int it = my_bid(); it < 256; it += my_nblk()) scan_item(wv_, B5, B6, B2, B3, B4, B7, BON, p.in[20], p.in[21], p.in[22], lds, it >> 5, (it >> 1) & 15, it & 1);
#else
            {
                const int half = my_nblk() >> 1;
                if (my_bid() < half) { for (int it = my_bid(); it < 128; it += half) scan2_item(wv_, B5, B6, B2, B3, YR, YR, BON, p.in[20], p.in[21], p.in[22], lds, it >> 4, it & 15); }
                else {
                    EpiBf16<0> Eg; Eg.O = B1; Eg.ldc = DM; Eg.bias = nullptr; run_gemm(wv_, lds, B7 + 128, (const bf16_t*)(ws + WS_L2G), DM, 256, 512, 256, 0, Eg, my_nblk() - half, my_bid() - half);
                    conv_phase(wv_, p.jobs, JOB_PERSIST + 9, JOB_PERSIST + 12, lds, my_nblk() - half, my_bid() - half);
                }
            }
#endif
            break;
        case 19:
#ifdef SCAN_DEBUG
            for (int it = my_bid(); it < 128; it += my_nblk()) scan2_item(wv_, B5, B6, B2, B3, B4, B5, (float*)(ws + WS_LSE), p.in[20], p.in[21], p.in[22], lds, it >> 4, it & 15);
#endif
            post_phase(wv_, YR, B2, B1, BON, p.in[27], p.in[28]); break;
        case 20: { EpiResid<true, true> E; E.X = XS0; E.O = XS1; E.scale = 1.0f; run_gemm(wv_, lds, B1, (const bf16_t*)(ws + WS_WO), DM, DM, DM, DM, 0, E); } break;
        case 21: norm_phase<true>(wv_, XS1, p.in[1] + 3 * DM, HN, 0); break;
#ifdef DBG_NAN
        case NPHASE: dbg_scan(wv_, p, (unsigned*)(p.ws + WS_FLAGS)); break;
        case NPHASE + 1: if (my_bid() == 0 && my_tid() == 0) { const unsigned c = *(volatile unsigned*)(p.ws + WS_FLAGS); const volatile unsigned* f = (const volatile unsigned*)(p.ws + WS_FLAGS); const float m0 = __uint_as_float(f[0]), md = __uint_as_float(f[1]), mb = __uint_as_float(f[2]), mbd = __uint_as_float(f[3]);
            (void)c; p.out[0] = DBG_SEL == 0 ? 1.0e6f * fminf(md / m0, 1.0e3f) : (DBG_SEL == 1 ? 1.0e6f * fminf(mbd / mb, 1.0e3f) : 1.0e6f * m0); } break;
#endif
        default: break;
        }
    }
}


__global__ void __launch_bounds__(512, 2) fwd_mega(const Params p) {
    extern __shared__ __attribute__((aligned(16))) unsigned char shm[];
    LAS unsigned char* lds = (LAS unsigned char*)shm;
    cg::grid_group grid = cg::this_grid();
#ifdef DBG_NAN
    const int nseq = p.ph_hi + 2;
#else
    const int nseq = p.ph_hi;
#endif
    const int wv0 = __builtin_amdgcn_readfirstlane((int)(threadIdx.x >> 6));
    volatile LAS unsigned* xst = (volatile LAS unsigned*)(lds + LDS_BYTES - 16);
    unsigned* xbar = (unsigned*)(p.ws + WS_BAR);
    {
        int wv_ = wv0; asm volatile("" : "+s"(wv_));
        if (my_tid() == 0) { xst[0] = 0u; xst[1] = 0u; (void)xb_add(&xbar[XB_XCNT(xb_xcc_id())], 1u); }
        __syncthreads();
    }
    for (int i = p.ph_lo; i < nseq; ++i) {
        const int ph = i < p.ph_hi ? i : NPHASE + (i - p.ph_hi);
        if (ph == 17) continue;
        const int reps = 1 + (int)((p.dup_mask >> ph) & 1u);
        for (int r = 0; r < reps; ++r) {
            int wv_ = wv0; asm volatile("" : "+s"(wv_));
            do_phase(wv_, ph, p, lds);
            if (i + 1 < nseq || r + 1 < reps) { if (p.ph_hi < 0) grid.sync(); else xcd_barrier_(wv_, xbar, xst); }
        }
    }
}

static void set_job(ConvJob& J, const float* src, const float* scale, bf16_t* dst, int Ks, int Ns, int ldd, int rb, int NR, int r0, int cb, int NC, int c0, int flags) {
    J.src = src; J.scale = scale; J.dst = dst; J.Ks = Ks; J.Ns = Ns; J.ldd = ldd; J.rb = rb; J.NR = NR; J.r0 = r0; J.cb = cb; J.NC = NC; J.c0 = c0; J.flags = flags; J.pad_ = 0;
}

extern "C" void kernel_launch(void* const* d_in, const int* in_sizes, int n_in, void* d_out, int out_size, void* d_ws, size_t ws_size, hipStream_t stream) {
    static int grid = 0;
    if (grid == 0) {
        if (n_in != 29 || out_size != T_TOK * DM || ws_size < WS_NEED) { fprintf(stderr, "kernel_launch: unexpected shapes / workspace (n_in %d out %d ws %zu need %zu)\n", n_in, out_size, ws_size, (size_t)WS_NEED); grid = -1; return; }
        if (hipFuncSetAttribute((const void*)fwd_mega, hipFuncAttributeMaxDynamicSharedMemorySize, LDS_BYTES) != hipSuccess) { fprintf(stderr, "kernel_launch: hipFuncSetAttribute failed\n"); grid = -1; return; }
        int dev = 0, cus = 0, per_cu = 0;
        hipGetDevice(&dev); hipDeviceGetAttribute(&cus, hipDeviceAttributeMultiprocessorCount, dev);
        hipOccupancyMaxActiveBlocksPerMultiprocessor(&per_cu, (const void*)fwd_mega, 512, LDS_BYTES);
        if (per_cu < 1) { fprintf(stderr, "kernel_launch: occupancy query says %d blocks per CU\n", per_cu); per_cu = 1; }
        (void)hipGetLastError();
        grid = cus * 1;
    }
    if (grid < 0) return;
    Params p{};
    for (int i = 0; i < 29; ++i) p.in[i] = (const float*)d_in[i];
    p.out = (float*)d_out; p.ws = (unsigned char*)d_ws;
    unsigned char* ws = (unsigned char*)d_ws;
    int nj = 0;
    const float* mix = p.in[11];
    set_job(p.jobs[nj++], p.in[7], nullptr, (bf16_t*)(ws + WS_WIN), 1024, 3072, 1024, 0, 3072, 0, 0, 1024, 0, 0);
    set_job(p.jobs[nj++], p.in[10], nullptr, (bf16_t*)(ws + WS_WOUT), 512, 1024, 512, 0, 1024, 0, 0, 512, 0, 0);
    set_job(p.jobs[nj++], p.in[23], nullptr, (bf16_t*)(ws + WS_WR), 1024, 1024, 1024, 0, 1024, 0, 0, 1024, 0, 0);
    set_job(p.jobs[nj++], p.in[24], nullptr, (bf16_t*)(ws + WS_WK), 1024, 1024, 1024, 0, 1024, 0, 0, 1024, 0, 0);
    set_job(p.jobs[nj++], p.in[25], nullptr, (bf16_t*)(ws + WS_WV), 1024, 1024, 1024, 0, 1024, 0, 0, 1024, 0, 0);
    set_job(p.jobs[nj++], p.in[26], nullptr, (bf16_t*)(ws + WS_WO), 1024, 1024, 1024, 0, 1024, 0, 0, 1024, 0, 0);
    set_job(p.jobs[nj++], p.in[13], mix + 1 * 1024, (bf16_t*)(ws + WS_L1), 1024, 64, 2048, 0, 64, 0, 0, 1024, 0, 1 << 1);
    set_job(p.jobs[nj++], p.in[13], mix + 1 * 1024, (bf16_t*)(ws + WS_L1), 1024, 64, 2048, 0, 64, 0, 1024, 1024, 1024, 2 << 1);
    set_job(p.jobs[nj++], p.in[16], mix + 4 * 1024, (bf16_t*)(ws + WS_L1), 1024, 64, 2048, 64, 64, 64, 0, 1024, 0, 1 << 1);
    set_job(p.jobs[nj++], p.in[16], mix + 4 * 1024, (bf16_t*)(ws + WS_L1), 1024, 64, 2048, 64, 64, 64, 1024, 1024, 1024, 2 << 1);
    set_job(p.jobs[nj++], p.in[18], mix + 5 * 1024, (bf16_t*)(ws + WS_L1), 1024, 160, 2048, 128, 192, 128, 0, 1024, 0, 1 << 1);
    set_job(p.jobs[nj++], p.in[18], mix + 5 * 1024, (bf16_t*)(ws + WS_L1), 1024, 160, 2048, 128, 192, 128, 1024, 1024, 1024, 2 << 1);
    set_job(p.jobs[nj++], nullptr, nullptr, (bf16_t*)(ws + WS_L1), 0, 0, 2048, 320, 192, 320, 0, 2048, 0, 0);
    set_job(p.jobs[nj++], p.in[14], nullptr, (bf16_t*)(ws + WS_L2W), 64, 1024, 128, 0, 1024, 0, 0, 128, 0, 0);
    set_job(p.jobs[nj++], p.in[17], nullptr, (bf16_t*)(ws + WS_L2A), 64, 1024, 128, 0, 1024, 0, 0, 128, 64, 0);
    set_job(p.jobs[nj++], p.in[19], nullptr, (bf16_t*)(ws + WS_L2G), 160, 1024, 256, 0, 1024, 0, 0, 256, 0, 0);
    for (int f = 0; f < 4; ++f) {
        const float* wg = p.in[2] + (size_t)f * DM * DFF; const float* wu = p.in[3] + (size_t)f * DM * DFF; const float* wd = p.in[4] + (size_t)f * DFF * DM;
        bf16_t* gu = (bf16_t*)(ws + (f == 3 ? WS_GU2 : WS_GU)); bf16_t* dn = (bf16_t*)(ws + (f == 3 ? WS_DN2 : WS_DN));
        set_job(p.jobs[nj++], wg, nullptr, gu, 1024, DFF, 1024, 0, DFF, 0, 0, 1024, 0, 1);
        set_job(p.jobs[nj++], wu, nullptr, gu, 1024, DFF, 1024, 128, DFF, 128, 0, 1024, 0, 1);
        set_job(p.jobs[nj++], wd, nullptr, dn, DFF, 1024, DFF, 0, 1024, 0, 0, DFF, 0, 0);
    }
    p.ph_lo = 0; p.ph_hi = NPHASE; p.dup_mask = DUPMASK;
#ifdef DBG_NAN
    hipMemsetAsync(ws + WS_FLAGS, 0, 256, stream);
#endif
    if (hipMemsetAsync(ws + WS_BAR, 0, XCD_BAR_WORDS * 4, stream) != hipSuccess) { fprintf(stderr, "kernel_launch: memset of the barrier words failed\n"); return; }
    void* args[] = {(void*)&p};
    hipError_t e = hipLaunchCooperativeKernel((const void*)fwd_mega, dim3(grid), dim3(512), args, LDS_BYTES, stream);
    if (e != hipSuccess) fprintf(stderr, "kernel_launch: cooperative launch failed: %s (grid %d)\n", hipGetErrorString(e), grid);
}
```
